# Optimizing an MI355X kernel written in HIP

```python
import math
import jax, jax.numpy as jnp
from jax import lax
import numpy as np

D_MODEL = 1024
BATCH = 16
SEQ = 2048
DEPTH = 1

MOBA_HEADS = 8
MOBA_HEAD_DIM = 64
MOBA_BLOCK = 256
MOBA_TOPK = 3
MOBA_Q_CHUNK = 64
MOBA_WIDTH = MOBA_HEADS * MOBA_HEAD_DIM
DIFF_HEADS = 4
DIFF_HEAD_DIM = 64
DIFF_Q_BLOCK = 128
DIFF_QK_WIDTH = DIFF_HEADS * 2 * DIFF_HEAD_DIM
DIFF_V_WIDTH = DIFF_HEADS * 2 * DIFF_HEAD_DIM
N_BRANCHES = 2
IN_COLS = 3 * MOBA_WIDTH + 2 * DIFF_QK_WIDTH + DIFF_V_WIDTH + N_BRANCHES * D_MODEL
ROPE_THETA = 10000.0
N_GROUPS = 4
EXPERTS_PER_GROUP = 8
N_EXPERTS = N_GROUPS * EXPERTS_PER_GROUP
EXPERT_TOPK = 2
D_EXPERT = 512
MOE_ROW_BLOCK = 128

EPS = 1e-6
NEG = -1e30

kernel_name = "hybrid_moba_diffattn_hmoe_block"


def rmsnorm(x, g):
    xf = x.astype(jnp.float32)
    var = jnp.mean(xf * xf, axis=-1, keepdims=True)
    return (xf * lax.rsqrt(var + EPS)).astype(x.dtype) * g


def rope_tables(seq, dim, dtype):
    inv = 1.0 / (ROPE_THETA ** (jnp.arange(0, dim, 2, dtype=jnp.float32) / dim))
    ang = jnp.arange(seq, dtype=jnp.float32)[:, None] * inv[None, :]
    ang = jnp.concatenate([ang, ang], axis=-1)
    return jnp.cos(ang).astype(dtype), jnp.sin(ang).astype(dtype)


def apply_rope(x, cos, sin):
    half = x.shape[-1] // 2
    rot = jnp.concatenate([-x[..., half:], x[..., :half]], axis=-1)
    return x * cos[:, None, :] + rot * sin[:, None, :]


def moba_attention(q, k, v):
    B, S, H, dh = q.shape
    nb = max(-(-S // MOBA_BLOCK), MOBA_TOPK)
    L = nb * MOBA_BLOCK
    pad = ((0, 0), (0, L - S), (0, 0), (0, 0))
    kb = jnp.pad(k, pad).reshape(B, nb, MOBA_BLOCK, H, dh).transpose(0, 3, 1, 2, 4)
    vb = jnp.pad(v, pad).reshape(B, nb, MOBA_BLOCK, H, dh).transpose(0, 3, 1, 2, 4)
    kmean = jnp.mean(kb.astype(jnp.float32), axis=3)
    qh = q.transpose(0, 2, 1, 3)
    nq = S // MOBA_Q_CHUNK
    scale = dh ** -0.5
    hidx = jnp.arange(H)[:, None, None]
    blk_ids = jnp.arange(nb)

    def one_batch(args):
        qb, kbh, vbh, kmh = args
        qcs = qb.reshape(H, nq, MOBA_Q_CHUNK, dh).transpose(1, 0, 2, 3)
        starts = jnp.arange(nq, dtype=jnp.int32) * MOBA_Q_CHUNK

        def one_chunk(a):
            qc, start = a
            blk = start // MOBA_BLOCK
            gate = jnp.einsum('hqd,hnd->hqn', qc.astype(jnp.float32), kmh)
            gate = jnp.where(blk_ids < blk, gate, -jnp.inf)
            _, sel = lax.top_k(gate, MOBA_TOPK)
            sel_valid = sel < blk
            ksel = kbh[hidx, sel].reshape(H, MOBA_Q_CHUNK, MOBA_TOPK * MOBA_BLOCK, dh)
            vsel = vbh[hidx, sel].reshape(H, MOBA_Q_CHUNK, MOBA_TOPK * MOBA_BLOCK, dh)
            s_sel = jnp.einsum('hqd,hqkd->hqk', qc, ksel).astype(jnp.float32) * scale
            sel_mask = jnp.repeat(sel_valid, MOBA_BLOCK, axis=-1)
            s_sel = jnp.where(sel_mask, s_sel, NEG)
            kown = lax.dynamic_index_in_dim(kbh, blk, axis=1, keepdims=False)
            vown = lax.dynamic_index_in_dim(vbh, blk, axis=1, keepdims=False)
            s_own = jnp.einsum('hqd,hkd->hqk', qc, kown).astype(jnp.float32) * scale
            qpos = start + jnp.arange(MOBA_Q_CHUNK)
            kpos = blk * MOBA_BLOCK + jnp.arange(MOBA_BLOCK)
            s_own = jnp.where(kpos[None, None, :] <= qpos[None, :, None], s_own, NEG)
            p = jax.nn.softmax(jnp.concatenate([s_sel, s_own], axis=-1), axis=-1).astype(v.dtype)
            n_sel = MOBA_TOPK * MOBA_BLOCK
            out = (jnp.einsum('hqk,hqkd->hqd', p[..., :n_sel], vsel)
                   + jnp.einsum('hqk,hkd->hqd', p[..., n_sel:], vown))
            return out

        o = lax.map(one_chunk, (qcs, starts))
        return o.transpose(0, 2, 1, 3).reshape(S, H, dh)

    return lax.map(one_batch, (qh, kb, vb, kmean))


def diff_attention(q1, q2, k1, k2, v, lam):
    B, S, H, dh = q1.shape
    nq = S // DIFF_Q_BLOCK
    scale = dh ** -0.5
    kpos = jnp.arange(S)
    q1b = q1.reshape(B, nq, DIFF_Q_BLOCK, H, dh).transpose(1, 0, 2, 3, 4)
    q2b = q2.reshape(B, nq, DIFF_Q_BLOCK, H, dh).transpose(1, 0, 2, 3, 4)
    starts = jnp.arange(nq, dtype=jnp.int32) * DIFF_Q_BLOCK

    def one_block(a):
        qb1, qb2, start = a
        qpos = start + jnp.arange(DIFF_Q_BLOCK)
        mask = kpos[None, :] <= qpos[:, None]
        s1 = jnp.einsum('bqhd,bkhd->bhqk', qb1, k1).astype(jnp.float32) * scale
        s2 = jnp.einsum('bqhd,bkhd->bhqk', qb2, k2).astype(jnp.float32) * scale
        p1 = jax.nn.softmax(jnp.where(mask, s1, NEG), axis=-1)
        p2 = jax.nn.softmax(jnp.where(mask, s2, NEG), axis=-1)
        pd = (p1 - lam * p2).astype(v.dtype)
        return jnp.einsum('bhqk,bkhe->bqhe', pd, v)

    o = lax.map(one_block, (q1b, q2b, starts))
    return o.transpose(1, 0, 2, 3, 4).reshape(B, S, H, 2 * dh)


def hier_moe(h, w_group, b_group, w_router, b_router, w1, w3, w2):
    B, S, D = h.shape
    T = B * S
    xt = h.reshape(T, D)
    g_logits = jnp.matmul(xt, w_group).astype(jnp.float32) + b_group
    p_group = jax.nn.softmax(g_logits, axis=-1)
    g_sel = jnp.argmax(g_logits, axis=-1)
    p_g = jnp.take_along_axis(p_group, g_sel[:, None], axis=-1)
    e_logits = (jnp.matmul(xt, w_router).astype(jnp.float32) + b_router).reshape(T, N_GROUPS, EXPERTS_PER_GROUP)
    e_logits = jnp.take_along_axis(e_logits, g_sel[:, None, None], axis=1)[:, 0]
    p_in = jax.nn.softmax(e_logits, axis=-1)
    top_p, top_e = lax.top_k(p_in, EXPERT_TOPK)
    top_w = top_p / jnp.sum(top_p, axis=-1, keepdims=True) * p_g
    expert_id = g_sel[:, None].astype(jnp.int32) * EXPERTS_PER_GROUP + top_e.astype(jnp.int32)

    A = T * EXPERT_TOPK
    m = MOE_ROW_BLOCK
    ids = expert_id.reshape(A)
    tok = jnp.repeat(jnp.arange(T, dtype=jnp.int32), EXPERT_TOPK)
    wts = top_w.reshape(A)
    order = jnp.argsort(ids)
    ids_s, tok_s, w_s = ids[order], tok[order], wts[order]
    counts = jax.ops.segment_sum(jnp.ones((A,), jnp.int32), ids, num_segments=N_EXPERTS)
    starts = jnp.cumsum(counts) - counts
    padded = (counts + m - 1) // m * m
    pends = jnp.cumsum(padded)
    pstarts = pends - padded
    dest = pstarts[ids_s] + (jnp.arange(A, dtype=jnp.int32) - starts[ids_s])
    P = (-(-A // m)) * m + N_EXPERTS * m
    nblk = P // m
    x_disp = jnp.zeros((P, D), h.dtype).at[dest].set(xt[tok_s])
    w_disp = jnp.zeros((P,), jnp.float32).at[dest].set(w_s)
    tok_disp = jnp.zeros((P,), jnp.int32).at[dest].set(tok_s)
    blk_expert = jnp.minimum(jnp.searchsorted(pends, jnp.arange(nblk, dtype=jnp.int32) * m, side='right'),
                             N_EXPERTS - 1).astype(jnp.int32)

    def expert_block(a):
        xblk, e = a
        gate = jnp.matmul(xblk, w1[e])
        up = jnp.matmul(xblk, w3[e])
        return jnp.matmul(jax.nn.silu(gate) * up, w2[e])

    yb = lax.map(expert_block, (x_disp.reshape(nblk, m, D), blk_expert))
    y = jax.ops.segment_sum(yb.reshape(P, D) * w_disp[:, None].astype(h.dtype), tok_disp, num_segments=T)
    return y.reshape(B, S, D)


def setup_inputs(seed: int = 0) -> dict:
    key = jax.random.key(seed)
    ks = jax.random.split(key, 24)
    f32 = jnp.float32
    L, D = DEPTH, D_MODEL

    def nrm(k, shape, scale):
        return jax.random.normal(k, shape, f32) * scale

    return {
        "x": nrm(ks[0], (BATCH, SEQ, D), 1.0),
        "g_mix": 1.0 + nrm(ks[1], (L, D), 0.02),
        "w_in": nrm(ks[2], (L, D, IN_COLS), D ** -0.5),
        "w_branch_moba": nrm(ks[3], (L, MOBA_WIDTH, D), MOBA_WIDTH ** -0.5),
        "w_branch_diff": nrm(ks[4], (L, DIFF_V_WIDTH, D), DIFF_V_WIDTH ** -0.5),
        "w_out": nrm(ks[5], (L, D, D), D ** -0.5),
        "diff_lambda_q1": nrm(ks[6], (L, DIFF_HEAD_DIM), 0.1),
        "diff_lambda_k1": nrm(ks[7], (L, DIFF_HEAD_DIM), 0.1),
        "diff_lambda_q2": nrm(ks[8], (L, DIFF_HEAD_DIM), 0.1),
        "diff_lambda_k2": nrm(ks[9], (L, DIFF_HEAD_DIM), 0.1),
        "diff_subln_g": 1.0 + nrm(ks[10], (L, 2 * DIFF_HEAD_DIM), 0.02),
        "g_ffn": 1.0 + nrm(ks[11], (L, D), 0.02),
        "w_group": nrm(ks[12], (L, D, N_GROUPS), D ** -0.5),
        "b_group": nrm(ks[13], (L, N_GROUPS), 0.01),
        "w_router": nrm(ks[14], (L, D, N_EXPERTS), D ** -0.5),
        "b_router": nrm(ks[15], (L, N_EXPERTS), 0.01),
        "w_expert_gate": nrm(ks[16], (L, N_EXPERTS, D, D_EXPERT), D ** -0.5),
        "w_expert_up": nrm(ks[17], (L, N_EXPERTS, D, D_EXPERT), D ** -0.5),
        "w_expert_down": nrm(ks[18], (L, N_EXPERTS, D_EXPERT, D), D_EXPERT ** -0.5),
        "g_final": 1.0 + nrm(ks[19], (D,), 0.02),
    }


def reference(x, g_mix, w_in, w_branch_moba, w_branch_diff, w_out,
              diff_lambda_q1, diff_lambda_k1, diff_lambda_q2, diff_lambda_k2, diff_subln_g,
              g_ffn, w_group, b_group, w_router, b_router,
              w_expert_gate, w_expert_up, w_expert_down, g_final):
    B, S, D = x.shape
    cos, sin = rope_tables(S, MOBA_HEAD_DIM, x.dtype)
    splits = [int(s) for s in np.cumsum([MOBA_WIDTH, MOBA_WIDTH, MOBA_WIDTH,
                                         DIFF_QK_WIDTH, DIFF_QK_WIDTH, DIFF_V_WIDTH])]
    for l in range(DEPTH):
        h = rmsnorm(x, g_mix[l])
        proj = jnp.matmul(h, w_in[l])
        qa, ka, va, qd, kd, vd, gates = jnp.split(proj, splits, axis=-1)
        qa = apply_rope(qa.reshape(B, S, MOBA_HEADS, MOBA_HEAD_DIM), cos, sin)
        ka = apply_rope(ka.reshape(B, S, MOBA_HEADS, MOBA_HEAD_DIM), cos, sin)
        va = va.reshape(B, S, MOBA_HEADS, MOBA_HEAD_DIM)
        o_a = moba_attention(qa, ka, va).reshape(B, S, MOBA_WIDTH)
        qd = apply_rope(qd.reshape(B, S, DIFF_HEADS * 2, DIFF_HEAD_DIM), cos, sin).reshape(B, S, DIFF_HEADS, 2, DIFF_HEAD_DIM)
        kd = apply_rope(kd.reshape(B, S, DIFF_HEADS * 2, DIFF_HEAD_DIM), cos, sin).reshape(B, S, DIFF_HEADS, 2, DIFF_HEAD_DIM)
        vd = vd.reshape(B, S, DIFF_HEADS, 2 * DIFF_HEAD_DIM)
        lambda_init = 0.8 - 0.6 * math.exp(-0.3 * l)
        lam = (jnp.exp(jnp.sum(diff_lambda_q1[l].astype(jnp.float32) * diff_lambda_k1[l].astype(jnp.float32)))
               - jnp.exp(jnp.sum(diff_lambda_q2[l].astype(jnp.float32) * diff_lambda_k2[l].astype(jnp.float32)))
               + lambda_init)
        o_d = diff_attention(qd[..., 0, :], qd[..., 1, :], kd[..., 0, :], kd[..., 1, :], vd, lam)
        o_d = (rmsnorm(o_d, diff_subln_g[l]) * (1.0 - lambda_init)).reshape(B, S, DIFF_V_WIDTH)
        gsig = jax.nn.sigmoid(gates).reshape(B, S, N_BRANCHES, D)
        merged = (gsig[:, :, 0] * jnp.matmul(o_a, w_branch_moba[l])
                  + gsig[:, :, 1] * jnp.matmul(o_d, w_branch_diff[l]))
        x = x + jnp.matmul(merged, w_out[l])
        h2 = rmsnorm(x, g_ffn[l])
        x = x + hier_moe(h2, w_group[l], b_group[l], w_router[l], b_router[l],
                         w_expert_gate[l], w_expert_up[l], w_expert_down[l])
    return rmsnorm(x, g_final)
```

```cpp
#include <hip/hip_runtime.h>
#include <hip/hip_bf16.h>
#include <cstdio>
#include <cstdint>
#include <cmath>

#ifndef MK_N_LAUNCHES
#define MK_N_LAUNCHES 1
#endif

constexpr int BATCH = 16, SEQ = 2048, T = BATCH * SEQ, DM = 1024, INC = 5120;
constexpr int NEXP = 32, DEXP = 512, LISTCAP = 32768;
constexpr float EPS = 1e-6f;
constexpr float C2 = 0.125f * 1.4426950408889634f;

namespace pg8 {
#define PG8_LAS __attribute__((address_space(3)))
typedef unsigned short bf16_t;
typedef short bf16x8 __attribute__((ext_vector_type(8)));
typedef float f32x4 __attribute__((ext_vector_type(4)));
typedef unsigned u32x4 __attribute__((ext_vector_type(4)));
constexpr int BM = 256, BK = 64, HALF = 128, HTB = HALF * BK * 2  , STAGE_BYTES = 8 * HTB, NXCD = 8, WGM = 8;

__host__ __device__ __forceinline__ int lds_byte(int r, int c) { const int st = (r >> 4) * 2 + (c >> 5), rr = r & 15, cc = c & 31, ob = rr * 64 + cc * 2; return st * 1024 + (ob ^ (((ob >> 9) & 1) << 5)); }
__host__ __device__ __forceinline__ void stage_rc(int b, int& R, int& C) { const int st = b / 1024, sb = b % 1024, swz = sb ^ (((sb >> 9) & 1) << 5); R = (st >> 1) * 16 + swz / 64; C = (st & 1) * 32 + (swz % 64) / 2; }
__host__ __device__ __forceinline__ int perm32(int rho) { const int n = rho >> 4, i = rho & 15; return 8 * (i >> 2) + 4 * n + (i & 3); }

struct Unit { int pm, pn, e, ti, cnt; };
struct Gemm { const bf16_t* A; const bf16_t* Bt; int M, N, K; };

struct StaticOrder {
    int nM, nN, nwg, G, c;
    __host__ __device__ void init(int M, int N, int G_, int c_) { nM = M / BM; nN = N / BM; nwg = nM * nN; G = G_; c = c_; }
    __host__ __device__ bool next(int i, Unit& u) const {
        const long L = (long)i * G + c; if (L >= nwg) return false;
        int wgid = (int)L; { const int q = nwg / NXCD, r = nwg % NXCD, xcd = wgid % NXCD, off = wgid / NXCD; wgid = (xcd < r ? xcd * (q + 1) : r * (q + 1) + (xcd - r) * q) + off; }
        const int nig = WGM * nN, gid = wgid / nig, fm = gid * WGM, gsz = (nM - fm) < WGM ? (nM - fm) : WGM;
        u.pm = fm + ((wgid % nig) % gsz); u.pn = (wgid % nig) / gsz; u.e = 0; u.ti = 0; u.cnt = 0; return true;
    }
    __device__ __forceinline__ unsigned arow(const Unit&, int) const { return 0u; }
    __device__ __forceinline__ void a_ready(const Unit&) const {}
    __device__ __forceinline__ void done(const Unit&) const {}
};

typedef float f32x2 __attribute__((ext_vector_type(2))); typedef __bf16 bf16x2v __attribute__((ext_vector_type(2)));
__device__ __forceinline__ unsigned cvt_pk_bf16(float lo, float hi) { f32x2 v = {lo, hi}; bf16x2v b = __builtin_convertvector(v, bf16x2v); return __builtin_bit_cast(unsigned, b); }
__device__ __forceinline__ u32x4 pack8(const f32x4 a, const f32x4 b) { u32x4 w; w.x = cvt_pk_bf16(a[0], a[1]); w.y = cvt_pk_bf16(a[2], a[3]); w.z = cvt_pk_bf16(b[0], b[1]); w.w = cvt_pk_bf16(b[2], b[3]); return w; }
__device__ __forceinline__ float bflo(unsigned w) { return __builtin_bit_cast(float, w << 16); }
__device__ __forceinline__ float bfhi(unsigned w) { return __builtin_bit_cast(float, w & 0xffff0000u); }
__device__ __forceinline__ void unpack8(const u32x4 w, f32x4& a, f32x4& b) { a = (f32x4){bflo(w.x), bfhi(w.x), bflo(w.y), bfhi(w.y)}; b = (f32x4){bflo(w.z), bfhi(w.z), bflo(w.w), bfhi(w.w)}; }
__device__ __forceinline__ float sigmoidf_(float x) { return __builtin_amdgcn_rcpf(1.0f + __builtin_amdgcn_exp2f(-1.4426950408889634f * x)); }

template <class Epi, class Sched, bool ALIGN_EPI, bool GATHER>
__device__ __forceinline__ void gemm_phase(PG8_LAS unsigned char* lds, const Gemm g, const Sched& S, const Epi& E) {
    const int tid = threadIdx.x, wid = __builtin_amdgcn_readfirstlane(tid >> 6), lane = tid & 63, wr = wid >> 2, wc = wid & 3, fr = lane & 15, fq = lane >> 4;
    const int K = g.K, nt = K / BK;
    unsigned voffA[2], voffB[2]; int rowA[2]; unsigned colA[2];
#pragma unroll
    for (int i = 0; i < 2; ++i) { int R, C; stage_rc(tid * 16 + i * 8192, R, C); const int Rb = (R & ~31) + perm32(R & 31);
        voffA[i] = (unsigned)(R * K + C) * 2u; voffB[i] = (unsigned)(Rb * K + C) * 2u; rowA[i] = R; colA[i] = (unsigned)C * 2u; }
    const size_t kstep = (size_t)(BK * 2);
    const size_t hstep = (size_t)HALF * K * 2;
    const size_t tstep = 2 * hstep;
    const unsigned ldsw = (unsigned)wid * 1024u;
    const int aoff = lds_byte(wr * 64 + fr, fq * 8), boff = lds_byte(wc * 32 + fr, fq * 8);
#define PG8_SA(b, h) (((b) * 2 + (h)) * HTB)
#define PG8_SB(b, h) ((4 + (b) * 2 + (h)) * HTB)
#define PG8_STAGE(bufoff, gbase, voff) do { _Pragma("unroll") for (int _i = 0; _i < 2; ++_i) \
        __builtin_amdgcn_global_load_lds((const unsigned*)((const char*)(gbase) + (voff)[_i]), (PG8_LAS unsigned*)(lds + (bufoff) + ldsw + _i * 8192), 16, 0, 0); } while (0)
#define PG8_STAGE_A(bufoff, ptr, H, ARR0, ARR1) do { if constexpr (GATHER) { if (H) PG8_STAGE(bufoff, ptr, ARR1); else PG8_STAGE(bufoff, ptr, ARR0); } else { PG8_STAGE(bufoff, (ptr) + (H) * hstep, voffA); } } while (0)
#define PG8_LDA(dst, b, h) do { _Pragma("unroll") for (int m = 0; m < 4; ++m) _Pragma("unroll") for (int k = 0; k < 2; ++k) dst[m][k] = *(const PG8_LAS bf16x8*)(lds + PG8_SA(b, h) + aoff + m * 2048 + k * 1024); } while (0)
#define PG8_LDB(dst, b, h) do { _Pragma("unroll") for (int n = 0; n < 2; ++n) _Pragma("unroll") for (int k = 0; k < 2; ++k) dst[n][k] = *(const PG8_LAS bf16x8*)(lds + PG8_SB(b, h) + boff + n * 2048 + k * 1024); } while (0)
#define PG8_MMA(ai, bj, At, Bt) do { __builtin_amdgcn_s_setprio(1); _Pragma("unroll") for (int m = 0; m < 4; ++m) _Pragma("unroll") for (int n = 0; n < 2; ++n) _Pragma("unroll") for (int k = 0; k < 2; ++k) \
        acc[ai][bj][m][n] = __builtin_amdgcn_mfma_f32_16x16x32_bf16(Bt[n][k], At[m][k], acc[ai][bj][m][n], 0, 0, 0); __builtin_amdgcn_s_setprio(0); } while (0)
#define PG8_WAIT_V(n) asm volatile("s_waitcnt vmcnt(" #n ")" ::: "memory")
#define PG8_WAIT_L(n) asm volatile("s_waitcnt lgkmcnt(" #n ")" ::: "memory")
#define PG8_BAR __builtin_amdgcn_s_barrier()
#define PG8_SCHED __builtin_amdgcn_sched_barrier(0)
    Unit cur, nxt; int ui = 0;
    if (!S.next(0, cur)) return;
    f32x4 acc[2][2][4][2];
#pragma unroll
    for (int a = 0; a < 2; ++a)
#pragma unroll
        for (int b = 0; b < 2; ++b)
#pragma unroll
            for (int m = 0; m < 4; ++m)
#pragma unroll
                for (int n = 0; n < 2; ++n) acc[a][b][m][n] = (f32x4){0.f, 0.f, 0.f, 0.f};
    bf16x8 At[4][2], B0[2][2], B1[2][2];
    unsigned v0[2] = {0u, 0u}, v1[2] = {0u, 0u}, nv0[2] = {0u, 0u}, nv1[2] = {0u, 0u};
    const char* cA = GATHER ? (const char*)g.A : (const char*)g.A + (size_t)cur.pm * tstep; const char* cB = (const char*)g.Bt + (size_t)cur.pn * tstep;
    if constexpr (GATHER) {
#pragma unroll
        for (int i = 0; i < 2; ++i) { v0[i] = S.arow(cur, rowA[i]) + colA[i]; v1[i] = S.arow(cur, HALF + rowA[i]) + colA[i]; }
    }
    S.a_ready(cur);
    PG8_STAGE(PG8_SB(0, 0), cB, voffB); PG8_STAGE(PG8_SB(0, 1), cB + hstep, voffB); PG8_STAGE_A(PG8_SA(0, 0), cA, 0, v0, v1); PG8_STAGE_A(PG8_SA(0, 1), cA, 1, v0, v1);
    if (wr == 1) PG8_BAR;
    PG8_WAIT_V(2); PG8_BAR;
    PG8_STAGE(PG8_SB(1, 0), cB + kstep, voffB); PG8_STAGE_A(PG8_SA(1, 0), cA + kstep, 0, v0, v1); PG8_STAGE(PG8_SB(1, 1), cB + hstep + kstep, voffB);
    PG8_WAIT_V(6); PG8_BAR;
    for (;;) {
        const bool has_next = S.next(ui + 1, nxt);
        const char* nA = GATHER ? cA : (has_next ? (const char*)g.A + (size_t)nxt.pm * tstep : cA); const char* nB = has_next ? (const char*)g.Bt + (size_t)nxt.pn * tstep : cB;
        if constexpr (GATHER) {
            if (has_next) {
#pragma unroll
                for (int i = 0; i < 2; ++i) { nv0[i] = S.arow(nxt, rowA[i]) + colA[i]; nv1[i] = S.arow(nxt, HALF + rowA[i]) + colA[i]; }
            } else {
#pragma unroll
                for (int i = 0; i < 2; ++i) { nv0[i] = v0[i]; nv1[i] = v1[i]; }
            }
        }
        for (int t = 0; t < nt; t += 2) {
            const bool last = (t == nt - 2);
            const char* a1 = cA + (size_t)(t + 1) * kstep;
            const char* a2 = last ? nA : cA + (size_t)(t + 2) * kstep; const char* b2 = last ? nB : cB + (size_t)(t + 2) * kstep;
            const char* a3 = a2 + kstep; const char* b3 = b2 + kstep;
            unsigned w0[2], w1[2];
#pragma unroll
            for (int i = 0; i < 2; ++i) { w0[i] = last ? nv0[i] : v0[i]; w1[i] = last ? nv1[i] : v1[i]; }
            if (last && has_next) S.a_ready(nxt);
            PG8_LDB(B0, 0, 0); PG8_LDB(B1, 0, 1); PG8_SCHED; PG8_LDA(At, 0, 0); PG8_STAGE_A(PG8_SA(1, 1), a1, 1, v0, v1);
            PG8_WAIT_V(8); PG8_WAIT_L(0); PG8_BAR; PG8_MMA(0, 0, At, B0); PG8_MMA(0, 1, At, B1); PG8_BAR; PG8_SCHED;
            PG8_LDA(At, 0, 1); PG8_STAGE(PG8_SB(0, 0), b2, voffB); PG8_STAGE(PG8_SB(0, 1), b2 + hstep, voffB); PG8_STAGE_A(PG8_SA(0, 0), a2, 0, w0, w1);
            PG8_WAIT_V(8); PG8_WAIT_L(0); PG8_BAR; PG8_MMA(1, 0, At, B0); PG8_MMA(1, 1, At, B1); PG8_BAR; PG8_SCHED;
            PG8_LDB(B0, 1, 0); PG8_LDB(B1, 1, 1); PG8_SCHED; PG8_LDA(At, 1, 0); PG8_STAGE_A(PG8_SA(0, 1), a2, 1, w0, w1);
            PG8_WAIT_V(8); PG8_WAIT_L(0); PG8_BAR; PG8_MMA(0, 0, At, B0); PG8_MMA(0, 1, At, B1); PG8_BAR; PG8_SCHED;
            PG8_LDA(At, 1, 1); PG8_STAGE(PG8_SB(1, 0), b3, voffB); PG8_STAGE(PG8_SB(1, 1), b3 + hstep, voffB); PG8_STAGE_A(PG8_SA(1, 0), a3, 0, w0, w1);
            PG8_WAIT_V(8); PG8_WAIT_L(0); PG8_BAR; PG8_MMA(1, 0, At, B0); PG8_MMA(1, 1, At, B1); PG8_BAR; PG8_SCHED;
        }
        if constexpr (ALIGN_EPI) { if (wr == 0) PG8_BAR; }
        E(acc, cur, wr, wc, fr, fq); S.done(cur);
        if (!has_next) break;
#pragma unroll
        for (int a = 0; a < 2; ++a)
#pragma unroll
            for (int b = 0; b < 2; ++b)
#pragma unroll
                for (int m = 0; m < 4; ++m)
#pragma unroll
                    for (int n = 0; n < 2; ++n) acc[a][b][m][n] = (f32x4){0.f, 0.f, 0.f, 0.f};
        cur = nxt; cA = nA; cB = nB; ++ui;
        if constexpr (GATHER) {
#pragma unroll
            for (int i = 0; i < 2; ++i) { v0[i] = nv0[i]; v1[i] = nv1[i]; }
        }
        if constexpr (ALIGN_EPI) { if (wr == 1) PG8_BAR; }
    }
    PG8_WAIT_V(0);
    if constexpr (!ALIGN_EPI) { if (wr == 0) PG8_BAR; }
    PG8_BAR;
#undef PG8_SA
#undef PG8_SB
#undef PG8_STAGE
#undef PG8_STAGE_A
#undef PG8_LDA
#undef PG8_LDB
#undef PG8_MMA
#undef PG8_WAIT_V
#undef PG8_WAIT_L
#undef PG8_BAR
#undef PG8_SCHED
}

#define EPI_ROWLOOP _Pragma("unroll") for (int ai = 0; ai < 2; ++ai) _Pragma("unroll") for (int m = 0; m < 4; ++m)

struct EpiProj {
    bf16_t* reg6;
    bf16_t* gates;
    const float* cosT; const float* sinT;
    float* kpart;
    __device__ __forceinline__ void operator()(const f32x4 (&acc)[2][2][4][2], const Unit& u, int wr, int wc, int fr, int fq) const {
        const int pn = u.pn, row0 = u.pm * BM + wr * 64 + fr;
        if (pn >= 12) {
            const int col0 = (pn - 12) * 256 + wc * 32 + 8 * fq;
            EPI_ROWLOOP { bf16_t* rowp = gates + (size_t)(row0 + ai * HALF + m * 16) * 2048 + col0;
#pragma unroll
                for (int bj = 0; bj < 2; ++bj) { f32x4 a = acc[ai][bj][m][0], b = acc[ai][bj][m][1];
#pragma unroll
                    for (int i = 0; i < 4; ++i) { a[i] = sigmoidf_(a[i]); b[i] = sigmoidf_(b[i]); }
                    *(u32x4*)(rowp + bj * HALF) = pack8(a, b); } }
            return;
        }
        const int rg = pn >> 1, pl = pn & 1;
        bf16_t* dst = reg6 + (size_t)rg * ((size_t)T * 512);
        if (rg == 2 || rg == 5) {
            const int col0 = pl * 256 + wc * 32 + 8 * fq;
            EPI_ROWLOOP { bf16_t* rowp = dst + (size_t)(row0 + ai * HALF + m * 16) * 512 + col0;
#pragma unroll
                for (int bj = 0; bj < 2; ++bj) *(u32x4*)(rowp + bj * HALF) = pack8(acc[ai][bj][m][0], acc[ai][bj][m][1]); }
            return;
        }
        const float sc = (rg == 0 || rg == 3) ? C2 : 1.0f;
        const int col0 = (pl * 4 + wc) * 64 + 8 * fq;
        f32x4 ks[4] = {{0.f, 0.f, 0.f, 0.f}, {0.f, 0.f, 0.f, 0.f}, {0.f, 0.f, 0.f, 0.f}, {0.f, 0.f, 0.f, 0.f}};
        EPI_ROWLOOP { const int row = row0 + ai * HALF + m * 16, s = row & (SEQ - 1);
            const f32x4 c0 = *(const f32x4*)(cosT + s * 32 + 8 * fq), c1 = *(const f32x4*)(cosT + s * 32 + 8 * fq + 4);
            const f32x4 s0 = *(const f32x4*)(sinT + s * 32 + 8 * fq), s1 = *(const f32x4*)(sinT + s * 32 + 8 * fq + 4);
            const f32x4 x1a = acc[ai][0][m][0], x1b = acc[ai][0][m][1], x2a = acc[ai][1][m][0], x2b = acc[ai][1][m][1];
            const f32x4 o1a = x1a * c0 - x2a * s0, o1b = x1b * c1 - x2b * s1, o2a = x2a * c0 + x1a * s0, o2b = x2b * c1 + x1b * s1;
            if (rg == 1) { ks[0] += o1a; ks[1] += o1b; ks[2] += o2a; ks[3] += o2b; }
            bf16_t* rowp = dst + (size_t)row * 512 + col0;
            *(u32x4*)(rowp) = pack8(o1a * sc, o1b * sc); *(u32x4*)(rowp + 32) = pack8(o2a * sc, o2b * sc); }
        if (rg == 1) {
#pragma unroll
            for (int q = 0; q < 4; ++q)
#pragma unroll
                for (int i = 0; i < 4; ++i) { float v = ks[q][i]; v += __shfl_xor(v, 1); v += __shfl_xor(v, 2); v += __shfl_xor(v, 4); v += __shfl_xor(v, 8); ks[q][i] = v; }
            if (fr == 0) { const int b = u.pm >> 3, blk = u.pm & 7, h = pl * 4 + wc;
                float* kp = kpart + ((((size_t)wr * 16 + b) * 8 + h) * 8 + blk) * 64 + 8 * fq;
                *(f32x4*)(kp) = ks[0]; *(f32x4*)(kp + 4) = ks[1]; *(f32x4*)(kp + 32) = ks[2]; *(f32x4*)(kp + 36) = ks[3]; }
        }
    }
};

template <int PASS> struct EpiMerge {
    bf16_t* merged; const bf16_t* gates;
    __device__ __forceinline__ void operator()(const f32x4 (&acc)[2][2][4][2], const Unit& u, int wr, int wc, int fr, int fq) const {
        const int row0 = u.pm * BM + wr * 64 + fr, col0 = u.pn * BM + wc * 32 + 8 * fq;
        EPI_ROWLOOP { const int row = row0 + ai * HALF + m * 16;
#pragma unroll
            for (int bj = 0; bj < 2; ++bj) { const int col = col0 + bj * HALF;
                f32x4 ga, gb; unpack8(*(const u32x4*)(gates + (size_t)row * 2048 + PASS * 1024 + col), ga, gb);
                f32x4 a = acc[ai][bj][m][0] * ga, b = acc[ai][bj][m][1] * gb;
                bf16_t* mp = merged + (size_t)row * 1024 + col;
                if (PASS == 1) { f32x4 pa, pb; unpack8(*(const u32x4*)mp, pa, pb); a += pa; b += pb; }
                *(u32x4*)mp = pack8(a, b); } }
    }
};

struct EpiRes {
    const float* x; float* x1; bf16_t* x1g; const float* gffn; float* ssqp;
    __device__ __forceinline__ void operator()(const f32x4 (&acc)[2][2][4][2], const Unit& u, int wr, int wc, int fr, int fq) const {
        const int row0 = u.pm * BM + wr * 64 + fr, col0 = u.pn * BM + wc * 32 + 8 * fq;
        f32x4 g[2][2];
#pragma unroll
        for (int bj = 0; bj < 2; ++bj) { g[bj][0] = *(const f32x4*)(gffn + col0 + bj * HALF); g[bj][1] = *(const f32x4*)(gffn + col0 + bj * HALF + 4); }
        EPI_ROWLOOP { const int row = row0 + ai * HALF + m * 16; float ss = 0.f;
#pragma unroll
            for (int bj = 0; bj < 2; ++bj) { const size_t off = (size_t)row * 1024 + col0 + bj * HALF;
                const f32x4 a = acc[ai][bj][m][0] + *(const f32x4*)(x + off), b = acc[ai][bj][m][1] + *(const f32x4*)(x + off + 4);
                *(f32x4*)(x1 + off) = a; *(f32x4*)(x1 + off + 4) = b;
                ss += (a[0] * a[0] + a[1] * a[1]) + (a[2] * a[2] + a[3] * a[3]) + (b[0] * b[0] + b[1] * b[1]) + (b[2] * b[2] + b[3] * b[3]);
                *(u32x4*)(x1g + off) = pack8(a * g[bj][0], b * g[bj][1]); }
            ss += __shfl_xor(ss, 16); ss += __shfl_xor(ss, 32);
            if (fq == 0) ssqp[(size_t)row * 16 + u.pn * 4 + wc] = ss; }
    }
};

struct EpiAct {
    bf16_t* act; const unsigned* list; const float* rstd;
    __device__ __forceinline__ void operator()(const f32x4 (&acc)[2][2][4][2], const Unit& u, int wr, int wc, int fr, int fq) const {
        const int pnl = u.pn & 3, col0 = pnl * 128 + wc * 32 + 8 * fq;
        EPI_ROWLOOP { const int idx = u.ti * 256 + ai * HALF + wr * 64 + m * 16 + fr;
            if (idx < u.cnt) { const unsigned a = list[(size_t)u.e * LISTCAP + idx]; const float rs = rstd[a >> 1];
                f32x4 o[2];
#pragma unroll
                for (int n = 0; n < 2; ++n) { const f32x4 gq = acc[ai][0][m][n] * rs, uq = acc[ai][1][m][n] * rs;
#pragma unroll
                    for (int i = 0; i < 4; ++i) o[n][i] = gq[i] * sigmoidf_(gq[i]) * uq[i]; }
                *(u32x4*)(act + (size_t)a * 512 + col0) = pack8(o[0], o[1]); } }
    }
};

struct EpiDown {
    bf16_t* yc; const unsigned* list; const float* wgt;
    __device__ __forceinline__ void operator()(const f32x4 (&acc)[2][2][4][2], const Unit& u, int wr, int wc, int fr, int fq) const {
        const int pnl = u.pn & 3, col0 = pnl * 256 + wc * 32 + 8 * fq;
        EPI_ROWLOOP { const int idx = u.ti * 256 + ai * HALF + wr * 64 + m * 16 + fr;
            if (idx < u.cnt) { const unsigned a = list[(size_t)u.e * LISTCAP + idx]; const float w = wgt[a];
#pragma unroll
                for (int bj = 0; bj < 2; ++bj) *(u32x4*)(yc + (size_t)a * 1024 + col0 + bj * HALF) = pack8(acc[ai][bj][m][0] * w, acc[ai][bj][m][1] * w); } }
    }
};

struct MoeOrder {
    const PG8_LAS int* tpre;
    const PG8_LAS int* cnts;
    const unsigned* list; int G, c, total, shift; unsigned rowbytes;
    __device__ __forceinline__ bool next(int i, Unit& u) const {
        const int L = i * G + c; if (L >= total) return false;
        const int tt = L >> 2; int e = 0;
        for (int j = 1; j < NEXP; ++j) e += (tt >= tpre[j]) ? 1 : 0;
        e = __builtin_amdgcn_readfirstlane(e);
        u.e = e; u.ti = __builtin_amdgcn_readfirstlane(tt - tpre[e]); u.cnt = __builtin_amdgcn_readfirstlane(cnts[e]); u.pn = e * 4 + (L & 3); u.pm = tt; return true;
    }
    __device__ __forceinline__ unsigned arow(const Unit& u, int tr) const { int idx = u.ti * 256 + tr; idx = idx < u.cnt ? idx : u.cnt - 1; const unsigned a = list[(size_t)u.e * LISTCAP + idx]; return (a >> shift) * rowbytes; }
    __device__ __forceinline__ void a_ready(const Unit&) const {}
    __device__ __forceinline__ void done(const Unit&) const {}
};
#undef EPI_ROWLOOP
}

namespace attn_body {
using bf16=__hip_bfloat16;
using bf16x8=__attribute__((ext_vector_type(8)))short;
using s16x4=__attribute__((ext_vector_type(4)))short;
using f32x16=__attribute__((ext_vector_type(16)))float;
using u32x4=__attribute__((ext_vector_type(4)))unsigned;
using f32x4=__attribute__((ext_vector_type(4)))float;
constexpr int SEQ=2048,D=64,PQ=512;
constexpr int NW=8,QBLK=32,QB=QBLK*NW,KVBLK=64,NQB=SEQ/QB;
constexpr int ATTN_UNIT_ROWS=QB;
__device__ __forceinline__ int crow(int r,int hi){return (r&3)+8*(r>>2)+4*hi;}
#define SBAR() __builtin_amdgcn_sched_barrier(0)
__device__ __forceinline__ void cmask(f32x16&p0,f32x16&p1,int jb,int qrel,int hi){
  const float NEG=-INFINITY; int kb=64*jb+4*hi;
  #pragma unroll
  for(int r=0;r<16;++r){int kv=kb+(r&3)+8*(r>>2); if(kv>qrel)p0[r]=NEG; if(kv+32>qrel)p1[r]=NEG;}
}

constexpr int NSLOT=3, SLOTB=8192;
constexpr int LDS_K=0, LDS_V=NSLOT*SLOTB, LDS_WS=2*NSLOT*SLOTB, LDS_OST=LDS_WS+NW*64*4, LDS_BYTES=LDS_OST+NW*4096;
constexpr float C2=0.125f*1.4426950408889634f;
__device__ __forceinline__ void glds16(const void*gsrc,unsigned lds_dst){unsigned keep;
  asm volatile("s_mov_b32 %0, m0\n\ts_mov_b32 m0, %2\n\ts_nop 0\n\tglobal_load_lds_dwordx4 %1, off\n\ts_mov_b32 m0, %0":"=&s"(keep):"v"(gsrc),"s"(lds_dst):"memory");}
__device__ __forceinline__ float max3f(float a,float b,float c){float r;asm("v_max3_f32 %0, %1, %2, %3":"=v"(r):"v"(a),"v"(b),"v"(c));return r;}
__device__ __forceinline__ float max2f(float a,float b){float r;asm("v_max_f32_e32 %0, %1, %2":"=v"(r):"v"(a),"v"(b));return r;}
__device__ __forceinline__ float fadd_s(float a,float b){float r;asm("v_add_f32_e32 %0, %1, %2":"=v"(r):"v"(a),"v"(b));return r;}
__device__ __forceinline__ float fsub_s(float a,float b){float r;asm("v_sub_f32_e32 %0, %1, %2":"=v"(r):"v"(a),"v"(b));return r;}
typedef float f32x2_t __attribute__((ext_vector_type(2))); typedef __bf16 bf16x2_t __attribute__((ext_vector_type(2)));
__device__ __forceinline__ unsigned cvtpk_s(float lo,float hi){f32x2_t v={lo,hi};bf16x2_t b=__builtin_convertvector(v,bf16x2_t);return __builtin_bit_cast(unsigned,b);}
#define WAIT_BAR(N) asm volatile("s_waitcnt vmcnt(" #N ") lgkmcnt(0)\n\ts_barrier":::"memory")

__device__ __forceinline__ void qkt(f32x16&p0,f32x16&p1,const char*Kslot,const bf16x8*qr,const f32x16&negm,int r32,int hi){
  const char*kb=Kslot+hi*1024+r32*16;
  #pragma unroll
  for(int d0=0;d0<4;++d0){
    const bf16x8 b0=*reinterpret_cast<const bf16x8*>(kb+d0*2048);
    const bf16x8 b1=*reinterpret_cast<const bf16x8*>(kb+d0*2048+512);
    if(d0==0){p0=__builtin_amdgcn_mfma_f32_32x32x16_bf16(b0,qr[0],negm,0,0,0);p1=__builtin_amdgcn_mfma_f32_32x32x16_bf16(b1,qr[0],negm,0,0,0);}
    else{p0=__builtin_amdgcn_mfma_f32_32x32x16_bf16(b0,qr[d0],p0,0,0,0);p1=__builtin_amdgcn_mfma_f32_32x32x16_bf16(b1,qr[d0],p1,0,0,0);}}
}
typedef __attribute__((address_space(3))) const char* lds_cptr;
typedef short v4i16_t __attribute__((ext_vector_type(4)));
__device__ __forceinline__ void kload8(bf16x8*kf,lds_cptr kp){
  kf[0]=*(const __attribute__((address_space(3))) bf16x8*)(kp);      kf[1]=*(const __attribute__((address_space(3))) bf16x8*)(kp+512);
  kf[2]=*(const __attribute__((address_space(3))) bf16x8*)(kp+2048); kf[3]=*(const __attribute__((address_space(3))) bf16x8*)(kp+2560);
  kf[4]=*(const __attribute__((address_space(3))) bf16x8*)(kp+4096); kf[5]=*(const __attribute__((address_space(3))) bf16x8*)(kp+4608);
  kf[6]=*(const __attribute__((address_space(3))) bf16x8*)(kp+6144); kf[7]=*(const __attribute__((address_space(3))) bf16x8*)(kp+6656);
}
__device__ __forceinline__ void kload2(bf16x8*kf,lds_cptr kp,int j){ kf[2*j]=*(const __attribute__((address_space(3))) bf16x8*)(kp+j*2048); kf[2*j+1]=*(const __attribute__((address_space(3))) bf16x8*)(kp+j*2048+512); }
__device__ __forceinline__ s16x4 vtr(lds_cptr p){ return __builtin_bit_cast(s16x4,__builtin_amdgcn_ds_read_tr16_b64_v4i16((__attribute__((address_space(3))) v4i16_t*)p)); }
__device__ __forceinline__ float rowmax(const f32x16&p0,const f32x16&p1){
  float a=max3f(p0[0],p0[1],p1[0]),b=max3f(p0[2],p0[3],p1[1]);a=max3f(a,p1[2],p1[3]);
  #pragma unroll
  for(int r=4;r<16;r+=4){a=max3f(a,p0[r],p0[r+1]);b=max3f(b,p0[r+2],p0[r+3]);a=max3f(a,p1[r],p1[r+1]);b=max3f(b,p1[r+2],p1[r+3]);}
  const float m=max2f(a,b);
  auto rr=__builtin_amdgcn_permlane32_swap(__float_as_uint(m),__float_as_uint(m),false,false);
  return max2f(__uint_as_float(rr[0]),__uint_as_float(rr[1]));
}
__device__ __forceinline__ void pv(f32x16*o,int vb,bf16x8 pa0,bf16x8 pa1,bf16x8 pa2,bf16x8 pa3){
  #pragma unroll
  for(int d0=0;d0<2;++d0){s16x4 lo[4],hi[4];
    #pragma unroll
    for(int ks=0;ks<4;++ks){
      asm volatile("ds_read_b64_tr_b16 %0,%1 offset:%c2":"=&v"(lo[ks]):"v"(vb),"i"(d0*4096+ks*1024):"memory");
      asm volatile("ds_read_b64_tr_b16 %0,%1 offset:%c2":"=&v"(hi[ks]):"v"(vb),"i"(d0*4096+ks*1024+512):"memory");}
    asm volatile("s_waitcnt lgkmcnt(0)":::"memory");SBAR();
    #define PK(k) (bf16x8){lo[k][0],lo[k][1],lo[k][2],lo[k][3],hi[k][0],hi[k][1],hi[k][2],hi[k][3]}
    o[d0]=__builtin_amdgcn_mfma_f32_32x32x16_bf16(pa0,PK(0),o[d0],0,0,0);
    o[d0]=__builtin_amdgcn_mfma_f32_32x32x16_bf16(pa1,PK(1),o[d0],0,0,0);
    o[d0]=__builtin_amdgcn_mfma_f32_32x32x16_bf16(pa2,PK(2),o[d0],0,0,0);
    o[d0]=__builtin_amdgcn_mfma_f32_32x32x16_bf16(pa3,PK(3),o[d0],0,0,0);
    #undef PK
  }
}

#ifndef ATTN_STORE16
#define ATTN_STORE16(p,v) (*(u32x4*)(p)=(v))
#endif
template<int THRL,bool MOBA,int PO> __device__ __forceinline__ void attn_unit(int qb,const bf16*Qb,const bf16*__restrict__ Kh,const bf16*__restrict__ Vh,bf16*Ob,const float*kmA,const float*kmB,char*shm){
  int tid_=threadIdx.x; asm volatile("":"+v"(tid_));
  const int tid=tid_,lane=tid&63,r32=lane&31,hi=lane>>5; const int wid=__builtin_amdgcn_readfirstlane(tid>>6);
  const int q0=qb*QB;
  const bf16*Qw=Qb+(long)(q0+wid*QBLK)*PQ;
  const unsigned lds0=(unsigned)(uintptr_t)shm;
  float*wsf=(float*)(shm+LDS_WS)+wid*64;
  const bf16*ksrc=Kh+(long)lane*PQ+wid*8;
  const bf16*vsrc=Vh+(long)(16*(wid&3)+(lane>>2))*PQ+(wid>>2)*32+(lane&3)*8;
  const unsigned kdst=lds0+LDS_K+wid*1024, vdst=lds0+LDS_V+wid*1024;
  #define DMA_K(t,slot) glds16(ksrc+(long)(t)*KVBLK*PQ,(unsigned)__builtin_amdgcn_readfirstlane(kdst+(slot)))
  #define DMA_V(t,slot) glds16(vsrc+(long)(t)*KVBLK*PQ,(unsigned)__builtin_amdgcn_readfirstlane(vdst+(slot)))
  const int vb0=(int)(lds0+LDS_V)+((lane>>4)&1)*32+(lane&3)*8+(4*hi+((lane&15)>>2))*64;
  const char*Kbase=shm+LDS_K; bf16x8 kf[8];
  const lds_cptr shm3=(lds_cptr)shm; const lds_cptr kp0=shm3+LDS_K+hi*1024+r32*16; const lds_cptr vp0=shm3+LDS_V+((lane>>4)&1)*32+(lane&3)*8+(4*hi+((lane&15)>>2))*64;
  const int NT=(q0+QB)/KVBLK;
  DMA_K(0,0);DMA_V(0,0);DMA_K(1,SLOTB);
  bf16x8 qr[4];
  #pragma unroll
  for(int d0=0;d0<4;++d0)qr[d0]=*reinterpret_cast<const bf16x8*>(&Qw[(long)r32*PQ+d0*16+hi*8]);
  unsigned selmask=0xFFu;
  if constexpr(MOBA){
    f32x16 gt=f32x16{}; const int jr=r32&7; const float kz=(r32<8)?(1.f/256.f):0.f;
    #pragma unroll
    for(int d0=0;d0<4;++d0){ const float*p0=kmA+jr*64+d0*16+hi*8; const float*p1=kmB+jr*64+d0*16+hi*8;
      const f32x4 a0=*(const f32x4*)p0,a1=*(const f32x4*)(p0+4),b0=*(const f32x4*)p1,b1=*(const f32x4*)(p1+4);
      u32x4 w; w[0]=cvtpk_s((a0[0]+b0[0])*kz,(a0[1]+b0[1])*kz); w[1]=cvtpk_s((a0[2]+b0[2])*kz,(a0[3]+b0[3])*kz); w[2]=cvtpk_s((a1[0]+b1[0])*kz,(a1[1]+b1[1])*kz); w[3]=cvtpk_s((a1[2]+b1[2])*kz,(a1[3]+b1[3])*kz);
      gt=__builtin_amdgcn_mfma_f32_32x32x16_bf16(__builtin_bit_cast(bf16x8,w),qr[d0],gt,0,0,0); }
    float gv[8];
    #pragma unroll
    for(int i=0;i<4;++i){ auto rr=__builtin_amdgcn_permlane32_swap(__float_as_uint(gt[i]),__float_as_uint(gt[i]),false,false); gv[i]=__uint_as_float(rr[0]); gv[4+i]=__uint_as_float(rr[1]); }
    unsigned sel=0u;
    #pragma unroll
    for(int k=0;k<3;++k){ float best=-INFINITY; int bi=8;
      #pragma unroll
      for(int j=0;j<8;++j){ const bool ok=(j<qb)&&(((sel>>j)&1u)==0u)&&(gv[j]>best); best=ok?gv[j]:best; bi=ok?j:bi; }
      sel|=(bi<8)?(1u<<bi):0u; }
    selmask=sel|(1u<<qb);
  }
  #define MMASK(P0,P1,t) do{ if constexpr(MOBA){ const bool keep_=((selmask>>((t)>>2))&1u)!=0u; _Pragma("unroll") for(int r=0;r<16;++r){P0[r]=keep_?P0[r]:-INFINITY;P1[r]=keep_?P1[r]:-INFINITY;} } }while(0)
  float mhat=0.f,l_reg=0.f;f32x16 o[2];o[0]=f32x16{};o[1]=f32x16{};f32x16 negm=f32x16{};asm volatile("":"+v"(negm));
  const int qrel=wid*QBLK+r32;
  #define CMASK(P0,P1,t) do{int jb_=(t)-(NT-4); if(jb_>=0)cmask(P0,P1,jb_,qrel,hi);}while(0)
  bool resc=false;
  #define START(P0,P1) do{ const float rm=rowmax(P0,P1); resc=false; \
    { const float dl=(rm==-INFINITY)?0.f:rm; mhat=fadd_s(mhat,dl); \
      _Pragma("unroll") for(int r=0;r<16;++r){P0[r]=fsub_s(P0[r],dl);P1[r]=fsub_s(P1[r],dl);} \
      _Pragma("unroll") for(int r=0;r<16;++r)negm[r]=-mhat; asm volatile("":"+v"(negm)); } \
    _Pragma("unroll") for(int r=0;r<16;++r)P0[r]=__builtin_amdgcn_exp2f(P0[r]); }while(0)
  #define RESC() do{ if(resc){ asm volatile("s_waitcnt lgkmcnt(0)":::"memory"); \
      _Pragma("unroll") for(int d_=0;d_<2;++d_) _Pragma("unroll") for(int r=0;r<16;++r)o[d_][r]*=wsf[crow(r,hi)]; } }while(0)
  f32x16 pA0,pA1,pB0,pB1;
  int sl_prev=0,sl_cur=0,sl_next=SLOTB;
  #define ROT() do{sl_prev=sl_cur;sl_cur=sl_next;sl_next=(sl_next==(NSLOT-1)*SLOTB)?0:sl_next+SLOTB;}while(0)
  DMA_K(2,2*SLOTB);
  WAIT_BAR(3);
  qkt(pA0,pA1,Kbase,qr,negm,r32,hi);asm volatile("s_nop 15\n\ts_nop 7":"+v"(pA0),"+v"(pA1));MMASK(pA0,pA1,0);CMASK(pA0,pA1,0);
  START(pA0,pA1);
  _Pragma("unroll") for(int r=0;r<16;++r)pA1[r]=__builtin_amdgcn_exp2f(pA1[r]);
  WAIT_BAR(0);
  DMA_K(3,0);DMA_V(1,SLOTB);
  ROT();
  kload8(kf,kp0+sl_cur);
  WAIT_BAR(2);
  s16x4 vlo[8],vhi[8]; u32x4 pw0,pw1,pw2,pw3;
  #define PKW(P,B) cvtpk_s(P[B],P[B+1])
  #define PAF(k) __builtin_bit_cast(bf16x8,pw##k)
  #define VFR(i) (bf16x8){vlo[i][0],vlo[i][1],vlo[i][2],vlo[i][3],vhi[i][0],vhi[i][1],vhi[i][2],vhi[i][3]}
  #define PIN(x) asm volatile("":"+v"(x))
  #define MX3(a,b,c) __builtin_fmaxf(__builtin_fmaxf((a),(b)),(c))
  #define GAPA(MF,A0,A1,A2,A3,W0,W1,PW) do{ MF; sacc+=A0; sacc+=A1; sacc+=A2; sacc+=A3; PIN(sacc); W0; W1; PIN(PW); SBAR(); }while(0)
  #define EX(v) __builtin_amdgcn_exp2f(v)
  #define GAPB(MF,X,B) do{ MF; X[B]=EX(X[B]); X[B+1]=EX(X[B+1]); X[B+2]=EX(X[B+2]); X[B+3]=EX(X[B+3]); PIN(X); SBAR(); }while(0)
  #define VRD(i) do{ vlo[i]=vtr(vp_+(((i)>>2)*4096+((i)&3)*1024)); vhi[i]=vtr(vp_+(((i)>>2)*4096+((i)&3)*1024+512)); }while(0)
  #define KRD(G,j) do{ if(G){ kload2(kf,kp0+sl_next,j); SBAR(); } }while(0)
  #define STEP(C0,C1,P0,P1,t,GK,GV,GL) do{ SBAR(); \
    const lds_cptr vp_=vp0+sl_prev; \
    VRD(0); SBAR(); float sacc=(P0[0]+P0[1]); \
    GAPA(C0=__builtin_amdgcn_mfma_f32_32x32x16_bf16(kf[0],qr[0],negm,0,0,0), P0[2],P0[3],P0[4],P0[5],     pw0[0]=PKW(P0,0), pw0[1]=PKW(P0,2), pw0); \
    VRD(4); SBAR(); GAPA(C1=__builtin_amdgcn_mfma_f32_32x32x16_bf16(kf[1],qr[0],negm,0,0,0), P0[6],P0[7],P0[8],P0[9],     pw0[2]=PKW(P0,4), pw0[3]=PKW(P0,6), pw0); \
    VRD(1); SBAR(); GAPA(C0=__builtin_amdgcn_mfma_f32_32x32x16_bf16(kf[2],qr[1],C0,0,0,0),   P0[10],P0[11],P0[12],P0[13], pw1[0]=PKW(P0,8), pw1[1]=PKW(P0,10), pw1); \
    VRD(5); SBAR(); GAPA(C1=__builtin_amdgcn_mfma_f32_32x32x16_bf16(kf[3],qr[1],C1,0,0,0),   P0[14],P0[15],P1[0],P1[1],   pw1[2]=PKW(P0,12),pw1[3]=PKW(P0,14), pw1); \
    VRD(2); SBAR(); GAPA(C0=__builtin_amdgcn_mfma_f32_32x32x16_bf16(kf[4],qr[2],C0,0,0,0),   P1[2],P1[3],P1[4],P1[5],     pw2[0]=PKW(P1,0), pw2[1]=PKW(P1,2), pw2); \
    VRD(6); SBAR(); GAPA(C1=__builtin_amdgcn_mfma_f32_32x32x16_bf16(kf[5],qr[2],C1,0,0,0),   P1[6],P1[7],P1[8],P1[9],     pw2[2]=PKW(P1,4), pw2[3]=PKW(P1,6), pw2); \
    VRD(3); SBAR(); GAPA(C0=__builtin_amdgcn_mfma_f32_32x32x16_bf16(kf[6],qr[3],C0,0,0,0),   P1[10],P1[11],P1[12],P1[13], pw3[0]=PKW(P1,8), pw3[1]=PKW(P1,10), pw3); \
    VRD(7); SBAR(); GAPA(C1=__builtin_amdgcn_mfma_f32_32x32x16_bf16(kf[7],qr[3],C1,0,0,0),   P1[14],P1[15],0.f,0.f,       pw3[2]=PKW(P1,12),pw3[3]=PKW(P1,14), pw3); \
    l_reg+=sacc; \
    if(GK){DMA_K((t)+3,sl_cur);} if(GV){DMA_V((t)+1,sl_next);} \
    MMASK(C0,C1,t); CMASK(C0,C1,t); \
    { float a=MX3(C0[0],C0[1],C1[0]),b=MX3(C0[2],C0[3],C1[1]); a=MX3(a,C1[2],C1[3]); \
      _Pragma("unroll") for(int r=4;r<16;r+=4){a=MX3(a,C0[r],C0[r+1]);b=MX3(b,C0[r+2],C0[r+3]);a=MX3(a,C1[r],C1[r+1]);b=MX3(b,C1[r+2],C1[r+3]);} \
      float rm=__builtin_fmaxf(a,b); { auto rr=__builtin_amdgcn_permlane32_swap(__float_as_uint(rm),__float_as_uint(rm),false,false); rm=__builtin_fmaxf(__uint_as_float(rr[0]),__uint_as_float(rr[1])); } \
      resc=false; \
      if(__builtin_expect(__any(rm>(float)THRL),0)){ const float dl=__builtin_fmaxf(rm,0.f); mhat+=dl; \
        _Pragma("unroll") for(int r=0;r<16;++r){C0[r]-=dl;C1[r]-=dl;} \
        _Pragma("unroll") for(int r=0;r<16;++r)negm[r]=-mhat; asm volatile("":"+v"(negm)); \
        const float f=__builtin_amdgcn_exp2f(-dl); l_reg*=f; if(hi==0)wsf[r32]=f; resc=true; } } \
    SBAR(); \
    GAPB(o[0]=__builtin_amdgcn_mfma_f32_32x32x16_bf16(PAF(0),VFR(0),o[0],0,0,0), C0,0); \
    GAPB(o[1]=__builtin_amdgcn_mfma_f32_32x32x16_bf16(PAF(0),VFR(4),o[1],0,0,0), C0,4); \
    KRD(GL,0); GAPB(o[0]=__builtin_amdgcn_mfma_f32_32x32x16_bf16(PAF(1),VFR(1),o[0],0,0,0), C0,8); \
    KRD(GL,1); GAPB(o[1]=__builtin_amdgcn_mfma_f32_32x32x16_bf16(PAF(1),VFR(5),o[1],0,0,0), C0,12); \
    KRD(GL,2); GAPB(o[0]=__builtin_amdgcn_mfma_f32_32x32x16_bf16(PAF(2),VFR(2),o[0],0,0,0), C1,0); \
    KRD(GL,3); GAPB(o[1]=__builtin_amdgcn_mfma_f32_32x32x16_bf16(PAF(2),VFR(6),o[1],0,0,0), C1,4); \
    GAPB(o[0]=__builtin_amdgcn_mfma_f32_32x32x16_bf16(PAF(3),VFR(3),o[0],0,0,0), C1,8); \
    GAPB(o[1]=__builtin_amdgcn_mfma_f32_32x32x16_bf16(PAF(3),VFR(7),o[1],0,0,0), C1,12); \
    }while(0)
  int t=1;
  #undef CMASK
  #define CMASK(P0,P1,t) do{}while(0)
  for(;t+5<NT;t+=2){
    STEP(pB0,pB1,pA0,pA1,t,true,true,true);     WAIT_BAR(2); RESC(); ROT();
    STEP(pA0,pA1,pB0,pB1,t+1,true,true,true);   WAIT_BAR(2); RESC(); ROT();
  }
  #undef CMASK
  #define CMASK(P0,P1,t) do{int jb_=(t)-(NT-4); if(jb_>=0)cmask(P0,P1,jb_,qrel,hi);}while(0)
  #define ENDW(tt) do{ if((tt)+3<NT){WAIT_BAR(2);} else if((tt)+2<NT){WAIT_BAR(1);} else {WAIT_BAR(0);} }while(0)
  for(;t+1<NT;t+=2){
    STEP(pB0,pB1,pA0,pA1,t,(t+3<NT),(t+1<NT),(t+1<NT));       ENDW(t);   RESC(); ROT();
    STEP(pA0,pA1,pB0,pB1,t+1,(t+4<NT),(t+2<NT),(t+2<NT));     ENDW(t+1); RESC(); ROT();
  }
  STEP(pB0,pB1,pA0,pA1,NT-1,false,false,false); RESC();
  { float sacc=pB0[0]+pB0[1]; _Pragma("unroll") for(int r=2;r<16;++r)sacc+=pB0[r]; _Pragma("unroll") for(int r=0;r<16;++r)sacc+=pB1[r]; l_reg+=sacc;
    pw0=(u32x4){PKW(pB0,0),PKW(pB0,2),PKW(pB0,4),PKW(pB0,6)};pw1=(u32x4){PKW(pB0,8),PKW(pB0,10),PKW(pB0,12),PKW(pB0,14)};pw2=(u32x4){PKW(pB1,0),PKW(pB1,2),PKW(pB1,4),PKW(pB1,6)};pw3=(u32x4){PKW(pB1,8),PKW(pB1,10),PKW(pB1,12),PKW(pB1,14)};
    SBAR(); pv(o,vb0+sl_cur,PAF(0),PAF(1),PAF(2),PAF(3)); }
  #undef PKW
  #undef PAF
  #undef VFR
  #undef PIN
  #undef MX3
  #undef GAPA
  #undef GAPB
  #undef EX
  #undef VRD
  #undef KRD
  #undef STEP
  #undef ENDW
  {auto rr=__builtin_amdgcn_permlane32_swap(__float_as_uint(l_reg),__float_as_uint(l_reg),false,false);l_reg=__uint_as_float(rr[0])+__uint_as_float(rr[1]);}
  if(hi==0)wsf[32+r32]=l_reg;asm volatile("s_waitcnt lgkmcnt(0)":::"memory");
  float rli[16];
  #pragma unroll
  for(int r=0;r<16;++r)rli[r]=__builtin_amdgcn_rcpf(wsf[32+crow(r,hi)]);
  bf16*Ow=Ob+(long)(q0+wid*QBLK)*PO;
  { bf16*stg=(bf16*)(shm+LDS_OST)+wid*2048;
    #pragma unroll
    for(int r=0;r<16;++r){const int orow=crow(r,hi);
      #pragma unroll
      for(int d0=0;d0<2;++d0)stg[orow*64+d0*32+r32]=__float2bfloat16(o[d0][r]*rli[r]);}
    asm volatile("s_waitcnt lgkmcnt(0)":::"memory");
    #pragma unroll
    for(int i=0;i<4;++i){const int row=i*8+(lane>>3),ch=lane&7; const u32x4 v=*(const u32x4*)(stg+row*64+ch*8); ATTN_STORE16(Ow+(long)row*PO+ch*8,v);} }
  asm volatile("s_waitcnt lgkmcnt(0)\n\ts_barrier":::"memory");
  #undef DMA_K
  #undef DMA_V
  #undef CMASK
  #undef MMASK
  #undef START
  #undef RESC
  #undef ROT
}
constexpr int ATTN_LDS_BYTES=LDS_BYTES;
#undef SBAR
#undef WAIT_BAR
}


constexpr int NWAVES = 8;
constexpr int N_LAUNCHES = MK_N_LAUNCHES;
constexpr int N_PHASES = 10;
static_assert(N_LAUNCHES == 1 || N_LAUNCHES == N_PHASES, "MK_N_LAUNCHES is 1 or 10");

constexpr size_t MiB = 1u << 20;
constexpr size_t WS_CTL = 0, CTL_ZERO_BYTES = 1 * MiB;
constexpr size_t WS_ROPE = 1 * MiB;
constexpr size_t WS_KPART = 2 * MiB;
constexpr size_t WS_SSQP = 3 * MiB;
constexpr size_t WS_RSTD = 5 * MiB;
constexpr size_t WS_WGT = 5 * MiB + 512 * 1024;
constexpr size_t WS_LIST = 6 * MiB;
constexpr size_t WS_WIN = 10 * MiB, WS_WBM = 20 * MiB, WS_WBD = 21 * MiB, WS_WOUT = 22 * MiB, WS_W13 = 24 * MiB, WS_W2 = 88 * MiB;
constexpr size_t WS_H = 120 * MiB;
constexpr size_t WS_R6 = 184 * MiB;
constexpr size_t WS_QA = WS_R6, WS_KA = WS_R6 + 32 * MiB, WS_VA = WS_R6 + 64 * MiB, WS_QD = WS_R6 + 96 * MiB;
constexpr size_t WS_OA = WS_QA;
constexpr size_t WS_ODF = WS_KA;
constexpr size_t WS_MERGED = WS_QD;
constexpr size_t WS_ACT = WS_QA;
constexpr size_t WS_YC = WS_VA;
constexpr size_t WS_GATES = 376 * MiB;
constexpr size_t WS_X1 = WS_GATES;
constexpr size_t WS_END = 512 * MiB;
static_assert(WS_W2 + (size_t)NEXP * 1024 * 512 * 2 <= WS_H && WS_H + (size_t)T * 1024 * 2 <= WS_R6 && WS_R6 + 6 * 32 * MiB <= WS_GATES && WS_GATES + (size_t)T * 1024 * 4 <= WS_END, "d_ws map");
static_assert(WS_YC + (size_t)2 * T * 1024 * 2 <= WS_GATES && WS_ACT + (size_t)2 * T * 512 * 2 <= WS_YC && WS_LIST + (size_t)NEXP * LISTCAP * 4 <= WS_WIN, "d_ws overlays");
constexpr int CW_TMO = 0, CW_CODE = 1;
constexpr int CW_BAR = 4096;
constexpr int CW_CNT = 8192;

constexpr int RING_OFF = 0, RING_BYTES = 131072;
constexpr int LDSCTL_OFF = RING_BYTES, MISC_OFF = LDSCTL_OFF + 320;
constexpr int LDS_BYTES = 147456;
static_assert(MISC_OFF + 128 <= LDS_BYTES, "LDS map");

#define GAS __attribute__((address_space(1)))
#define LAS __attribute__((address_space(3)))
typedef unsigned short bf16;
typedef unsigned v4u __attribute__((ext_vector_type(4)));
typedef float f32x4 __attribute__((ext_vector_type(4)));
typedef short bf16x8 __attribute__((ext_vector_type(8)));
typedef GAS unsigned gu32;
typedef GAS unsigned long long gu64;
#define RLX_AGENT __ATOMIC_RELAXED, __HIP_MEMORY_SCOPE_AGENT
#define LDS_WAIT() asm volatile("s_waitcnt lgkmcnt(0)" ::: "memory")
#define VM_WAIT() asm volatile("s_waitcnt vmcnt(0)" ::: "memory")
__device__ __forceinline__ unsigned long long rt() { return __builtin_amdgcn_s_memrealtime(); }
__device__ __forceinline__ unsigned f2bf(float f) { unsigned u = __builtin_bit_cast(unsigned, f); return (u + 0x7fffu + ((u >> 16) & 1u)) >> 16; }
__device__ __forceinline__ unsigned pk2(float lo, float hi) { return f2bf(lo) | (f2bf(hi) << 16); }

#define XB_TMO      128
#define XB_XCNT(j)  (256  + 64 * (j))
#define XB_XSUB(j)  (1280 + 64 * (j))
#define XB_XGEN(j)  (2304 + 64 * (j))
#define XB_TOP      3328
#define XB_TOPGEN   3392
#define XCD_BAR_WORDS 3456
#define XB_SPIN_CAP (1u << 18)

__device__ __forceinline__ unsigned xb_ld(unsigned* p)              { return __hip_atomic_load(p, __ATOMIC_RELAXED, __HIP_MEMORY_SCOPE_AGENT); }
__device__ __forceinline__ unsigned xb_add(unsigned* p, unsigned v) { return __hip_atomic_fetch_add(p, v, __ATOMIC_RELAXED, __HIP_MEMORY_SCOPE_AGENT); }
__device__ __forceinline__ unsigned xb_xcc_id() { return (unsigned)__builtin_amdgcn_s_getreg((3 << 11) | 20) & 0xFu; }
#define XB_SPIN(cond, bar) do { unsigned _sp = 0; while (cond) { __builtin_amdgcn_s_sleep(1); \
    if ((++_sp & 255u) == 0u) { if (xb_ld(&(bar)[XB_TMO])) break; if (_sp > XB_SPIN_CAP) { atomicAdd(&(bar)[XB_TMO], 1u); break; } } } } while (0)

struct XcdBarrier {
    unsigned* bar; unsigned x;
    volatile LAS unsigned* st;
};

__device__ __forceinline__ XcdBarrier xcd_barrier_post(unsigned* bar, volatile LAS unsigned* st) {
    XcdBarrier b; b.bar = bar; b.x = xb_xcc_id(); b.st = st;
    if (threadIdx.x == 0) (void)xb_add(&bar[XB_XCNT(b.x)], 1u);
    return b;
}
__device__ __forceinline__ void xcd_barrier_complete(unsigned* bar, unsigned x, unsigned& nloc, unsigned& nx) {
    const unsigned G = gridDim.x * gridDim.y * gridDim.z;
    unsigned sum, cnt, mine, sp = 0u;
    for (;;) {
        sum = 0u; cnt = 0u; mine = 0u;
#pragma unroll
        for (unsigned j = 0; j < 16; ++j) { const unsigned c = xb_ld(&bar[XB_XCNT(j)]); sum += c; cnt += (c > 0u) ? 1u : 0u; mine = (j == x) ? c : mine; }
        if (sum == G) break;
        __builtin_amdgcn_s_sleep(1);
        if ((++sp & 255u) == 0u) { if (xb_ld(&bar[XB_TMO])) break; if (sp > XB_SPIN_CAP) { atomicAdd(&bar[XB_TMO], 1u); break; } }
    }
    nloc = mine > 0u ? mine : 1u; nx = cnt > 0u ? cnt : 1u;
}

__device__ __forceinline__ void xcd_barrier(const XcdBarrier& b) {
    asm volatile("s_waitcnt vmcnt(0)" ::: "memory");
    __syncthreads();
    if (threadIdx.x == 0) {
        unsigned* bar = b.bar;
        __builtin_amdgcn_s_waitcnt(0);
        unsigned nloc = b.st[0], nx = b.st[1];
        if (nloc == 0u) { xcd_barrier_complete(bar, b.x, nloc, nx); b.st[0] = nloc; b.st[1] = nx; }
        const unsigned old = xb_add(&bar[XB_XSUB(b.x)], 1u);
        const unsigned gen = old / nloc;
        if (old + 1u == (gen + 1u) * nloc) {
            __builtin_amdgcn_fence(__ATOMIC_RELEASE, "agent");
            asm volatile("s_waitcnt vmcnt(0)" ::: "memory");
            const unsigned og = xb_add(&bar[XB_TOP], 1u);
            const unsigned tg = og / nx;
            if (og + 1u == (tg + 1u) * nx) xb_add(&bar[XB_TOPGEN], 1u);
            else XB_SPIN(xb_ld(&bar[XB_TOPGEN]) == tg, bar);
            __builtin_amdgcn_fence(__ATOMIC_ACQUIRE, "agent");
            xb_add(&bar[XB_XGEN(b.x)], 1u);
            asm volatile("s_waitcnt vmcnt(0)" ::: "memory");
        } else {
            XB_SPIN(xb_ld(&bar[XB_XGEN(b.x)]) == gen, bar);
            __builtin_amdgcn_fence(__ATOMIC_ACQUIRE, "agent");
            asm volatile("s_waitcnt vmcnt(0)" ::: "memory");
        }
    }
    __syncthreads();
}

struct Args { const float* in[20]; float* out; unsigned char* ws; int ph_lo, ph_hi; };

typedef float f32x16 __attribute__((ext_vector_type(16)));
typedef unsigned u32x2 __attribute__((ext_vector_type(2)));

__device__ __forceinline__ float wave_sum(float v) {
#pragma unroll
    for (int o = 1; o < 64; o <<= 1) v += __shfl_xor(v, o);
    return v;
}
__device__ __forceinline__ float bf2f_lo(unsigned w) { return __builtin_bit_cast(float, w << 16); }
__device__ __forceinline__ float bf2f_hi(unsigned w) { return __builtin_bit_cast(float, w & 0xffff0000u); }

__device__ __forceinline__ int rowmap(int code, int n0) {
    if (code == 1) { const int pn = n0 >> 8; const bool rope = (pn < 4) || (pn >= 6 && pn < 10); if (!rope) return n0; const int hh = (n0 & 255) >> 6, half = (n0 & 63) >> 5; return (pn << 8) + 128 * half + 32 * hh; }
    if (code == 2) return 256 * (n0 >> 7) + (n0 & 127);
    if (code == 3) return 256 * (n0 >> 7) + 128 + (n0 & 127);
    return n0;
}
__device__ __forceinline__ void p0_transpose_item(const float* W, int K, int N, bf16* WT, int code, LAS float* scr, int item, int lane) {
    const int nblk = N / 32, kb = item / nblk, nb = item % nblk, k0 = 64 * kb, n0 = 32 * nb, r0 = rowmap(code, n0);
#pragma unroll 8
    for (int i = 0; i < 32; ++i) { const int kk = 2 * i + (lane >> 5); scr[kk * 33 + (lane & 31)] = W[(size_t)(k0 + kk) * N + n0 + (lane & 31)]; }
    LDS_WAIT(); asm volatile("" ::: "memory");
    const int c = lane & 7;
#pragma unroll
    for (int j = 0; j < 4; ++j) { const int n = (lane >> 3) + 8 * j; const LAS float* s = scr + (8 * c) * 33 + n;
        v4u o; o.x = pk2(s[0 * 33], s[1 * 33]); o.y = pk2(s[2 * 33], s[3 * 33]); o.z = pk2(s[4 * 33], s[5 * 33]); o.w = pk2(s[6 * 33], s[7 * 33]);
        *(GAS v4u*)(WT + (size_t)(r0 + n) * K + k0 + 8 * c) = o; }
    LDS_WAIT(); asm volatile("" ::: "memory");
}
__device__ __forceinline__ void p0_prologue(LAS unsigned char* lds, const Args& A, int vcu, int G, int tid) {
    const int lane = tid & 63, wave = __builtin_amdgcn_readfirstlane(tid >> 6);
    unsigned char* ws = A.ws;
    LAS float* scr = (LAS float*)(lds + RING_OFF + wave * 16384);
    const int gw = vcu * NWAVES + wave, NGW = G * NWAVES;
    constexpr int I_IN = 16 * 160, I_BM = 8 * 32, I_OUT = 16 * 32, I_E = 256;
    constexpr int NITEMS = I_IN + 2 * I_BM + I_OUT + 3 * NEXP * I_E;
    for (int it = gw; it < NITEMS; it += NGW) {
        int r = it;
        if (r < I_IN) { p0_transpose_item(A.in[2], 1024, INC, (bf16*)(ws + WS_WIN), 1, scr, r, lane); continue; } r -= I_IN;
        if (r < I_BM) { p0_transpose_item(A.in[3], 512, 1024, (bf16*)(ws + WS_WBM), 0, scr, r, lane); continue; } r -= I_BM;
        if (r < I_BM) { p0_transpose_item(A.in[4], 512, 1024, (bf16*)(ws + WS_WBD), 0, scr, r, lane); continue; } r -= I_BM;
        if (r < I_OUT) { p0_transpose_item(A.in[5], 1024, 1024, (bf16*)(ws + WS_WOUT), 0, scr, r, lane); continue; } r -= I_OUT;
        if (r < NEXP * I_E) { const int e = r >> 8; p0_transpose_item(A.in[16] + (size_t)e * 1024 * 512, 1024, 512, (bf16*)(ws + WS_W13) + (size_t)e * 1024 * 1024, 2, scr, r & 255, lane); continue; } r -= NEXP * I_E;
        if (r < NEXP * I_E) { const int e = r >> 8; p0_transpose_item(A.in[17] + (size_t)e * 1024 * 512, 1024, 512, (bf16*)(ws + WS_W13) + (size_t)e * 1024 * 1024, 3, scr, r & 255, lane); continue; } r -= NEXP * I_E;
        { const int e = r >> 8; p0_transpose_item(A.in[18] + (size_t)e * 512 * 1024, 512, 1024, (bf16*)(ws + WS_W2) + (size_t)e * 1024 * 512, 0, scr, r & 255, lane); }
    }
    { const float* gm = A.in[1]; f32x4 gv[4];
#pragma unroll
        for (int j = 0; j < 4; ++j) gv[j] = ((const GAS f32x4*)gm)[lane + 64 * j];
        bf16* H = (bf16*)(ws + WS_H);
        for (int m = gw; m < T; m += NGW) {
            const GAS f32x4* xr = (const GAS f32x4*)(A.in[0] + (size_t)m * DM) + lane;
            f32x4 v[4]; float s = 0.f;
#pragma unroll
            for (int j = 0; j < 4; ++j) { v[j] = xr[64 * j]; s += (v[j].x * v[j].x + v[j].y * v[j].y) + (v[j].z * v[j].z + v[j].w * v[j].w); }
            const float rstd = 1.0f / sqrtf(wave_sum(s) * (1.f / DM) + EPS);
            GAS unsigned long long* o8 = (GAS unsigned long long*)(H + (size_t)m * DM) + lane;
#pragma unroll
            for (int j = 0; j < 4; ++j) { const f32x4 o = v[j] * rstd * gv[j]; o8[64 * j] = (unsigned long long)pk2(o.x, o.y) | ((unsigned long long)pk2(o.z, o.w) << 32); }
        }
    }
    { float* cosT = (float*)(ws + WS_ROPE); float* sinT = cosT + SEQ * 32;
        for (int idx = vcu * (NWAVES * 64) + tid; idx < SEQ * 32; idx += G * NWAVES * 64) { const int s = idx >> 5, d = idx & 31;
            const float inv = 1.0f / powf(10000.0f, (float)(2 * d) / 64.0f); const float ang = (float)s * inv; cosT[idx] = cosf(ang); sinT[idx] = sinf(ang); } }
}

__device__ __forceinline__ void p2_attention(char* lds, unsigned char* ws, int vcu, int G) {
    using attn_body::bf16;
    const bf16* QA = (const bf16*)(ws + WS_QA); const bf16* QD = (const bf16*)(ws + WS_QD);
    const float* kpart = (const float*)(ws + WS_KPART);
    constexpr size_t R = (size_t)T * 512;
    { constexpr int NP = BATCH * 8 * 4; const int per = (NP + G - 1) / G; const int pend = (vcu + 1) * per < NP ? (vcu + 1) * per : NP;
        for (int p = vcu * per; p < pend; ++p) { const int bh = p >> 2, s = p & 3, b = bh >> 3, h = bh & 7; const size_t ro = (size_t)b * SEQ * 512 + h * 64;
            for (int half = 0; half < 2; ++half) { const int qb = half ? 7 - s : s;
                attn_body::attn_unit<8, true, 512>(qb, QA + ro, QA + R + ro, QA + 2 * R + ro, (bf16*)(ws + WS_OA) + ro, kpart + (((size_t)b) * 8 + h) * 512, kpart + (((size_t)16 + b) * 8 + h) * 512, lds); } } }
    { constexpr int NP = BATCH * 16 * 4; const int per = (NP + G - 1) / G; const int pend = (vcu + 1) * per < NP ? (vcu + 1) * per : NP;
        for (int p = vcu * per; p < pend; ++p) { const int bx = p >> 2, s = p & 3, b = bx >> 4, x = bx & 15, hd = x >> 2, m = (x >> 1) & 1, c = x & 1; const size_t rb = (size_t)b * SEQ;
            for (int half = 0; half < 2; ++half) { const int qb = half ? 7 - s : s;
                attn_body::attn_unit<8, false, 1024>(qb, QD + rb * 512 + (hd * 2 + m) * 64, QD + R + rb * 512 + (hd * 2 + m) * 64, QD + 2 * R + rb * 512 + (hd * 2 + c) * 64,
                                                      (bf16*)(ws + WS_H) + rb * 1024 + x * 64, nullptr, nullptr, lds); } } }
}

__device__ __forceinline__ void p3_combine(const Args& A, int vcu, int G, int tid) {
    const int lane = tid & 63, wave = __builtin_amdgcn_readfirstlane(tid >> 6);
    const int gw = vcu * NWAVES + wave, NGW = G * NWAVES;
    const float lam = __expf(wave_sum(A.in[6][lane] * A.in[7][lane])) - __expf(wave_sum(A.in[8][lane] * A.in[9][lane])) + 0.2f;
    const int hd = lane >> 4, e0 = (lane & 15) * 8, c = e0 >> 6, d0 = e0 & 63;
    float g[8];
#pragma unroll
    for (int j = 0; j < 8; ++j) g[j] = A.in[10][e0 + j] * 0.8f;
    const bf16* OD = (const bf16*)(A.ws + WS_H); bf16* OF = (bf16*)(A.ws + WS_ODF);
    for (int row = gw; row < T; row += NGW) {
        const v4u a = *(const GAS v4u*)(OD + (size_t)row * 1024 + (hd * 4 + c) * 64 + d0), b = *(const GAS v4u*)(OD + (size_t)row * 1024 + (hd * 4 + 2 + c) * 64 + d0);
        float v[8];
#pragma unroll
        for (int j = 0; j < 4; ++j) { v[2 * j] = bf2f_lo(a[j]) - lam * bf2f_lo(b[j]); v[2 * j + 1] = bf2f_hi(a[j]) - lam * bf2f_hi(b[j]); }
        float ss = 0.f;
#pragma unroll
        for (int j = 0; j < 8; ++j) ss += v[j] * v[j];
        ss += __shfl_xor(ss, 1); ss += __shfl_xor(ss, 2); ss += __shfl_xor(ss, 4); ss += __shfl_xor(ss, 8);
        const float rstd = 1.0f / sqrtf(ss * (1.f / 128.f) + EPS);
        v4u o;
#pragma unroll
        for (int j = 0; j < 4; ++j) o[j] = pk2(v[2 * j] * rstd * g[2 * j], v[2 * j + 1] * rstd * g[2 * j + 1]);
        *(GAS v4u*)(OF + (size_t)row * 512 + hd * 128 + e0) = o;
    }
}

__device__ __forceinline__ void p6_router(LAS unsigned char* lds, const Args& A, int vcu, int G, int tid) {
    const int lane = tid & 63, wave = __builtin_amdgcn_readfirstlane(tid >> 6), r32 = lane & 31, hi = lane >> 5;
    constexpr int WLS = 1032;
    LAS bf16* Wl = (LAS bf16*)lds;
    LAS int* lcnt = (LAS int*)(lds + 36 * WLS * 2); LAS int* lbase = lcnt + 32;
    const float* wgroup = A.in[12]; const float* bgroup = A.in[13]; const float* wrouter = A.in[14]; const float* brouter = A.in[15];
    for (int idx = tid; idx < 32 * 1024; idx += NWAVES * 64) { const int e = idx & 31, k = idx >> 5; Wl[(4 + e) * WLS + k] = (bf16)f2bf(wrouter[idx]); }
    for (int idx = tid; idx < 4 * 1024; idx += NWAVES * 64) { const int n = idx & 3, k = idx >> 2; Wl[n * WLS + k] = (bf16)f2bf(wgroup[idx]); }
    __syncthreads();
    const bf16* x1g = (const bf16*)(A.ws + WS_H); const float* ssqp = (const float*)(A.ws + WS_SSQP);
    unsigned* cnt = (unsigned*)(A.ws + WS_CTL) + CW_CNT; unsigned* list = (unsigned*)(A.ws + WS_LIST); float* wgt = (float*)(A.ws + WS_WGT); float* rstd = (float*)(A.ws + WS_RSTD);
    for (int chunk = vcu; chunk < T / 128; chunk += G) {
        if (tid < 32) lcnt[tid] = 0;
        __syncthreads();
        const int row = chunk * 128 + (wave & 3) * 32 + r32;
        int e1 = 0, e2 = 0, p1 = 0, p2 = 0; float w1 = 0.f, w2 = 0.f, rs = 0.f;
        if (wave < 4) {
            f32x16 acc0 = {}, acc1 = {};
            const bf16* xp = x1g + (size_t)row * 1024 + hi * 8;
            const LAS bf16* ap0 = Wl + (4 + r32) * WLS + hi * 8; const LAS bf16* ap1 = Wl + (r32 & 3) * WLS + hi * 8;
#pragma unroll 4
            for (int s = 0; s < 64; ++s) {
                const bf16x8 b = *(const GAS bf16x8*)(xp + s * 16);
                const bf16x8 a0 = *(const LAS bf16x8*)(ap0 + s * 16);
                bf16x8 a1 = *(const LAS bf16x8*)(ap1 + s * 16); if (r32 >= 4) a1 = (bf16x8){0, 0, 0, 0, 0, 0, 0, 0};
                acc0 = __builtin_amdgcn_mfma_f32_32x32x16_bf16(a0, b, acc0, 0, 0, 0);
                acc1 = __builtin_amdgcn_mfma_f32_32x32x16_bf16(a1, b, acc1, 0, 0, 0);
            }
            float el[32], gl[4];
#pragma unroll
            for (int r = 0; r < 16; ++r) { auto rr = __builtin_amdgcn_permlane32_swap(__float_as_uint(acc0[r]), __float_as_uint(acc0[r]), false, false);
                el[(r & 3) + 8 * (r >> 2)] = __uint_as_float(rr[0]); el[(r & 3) + 8 * (r >> 2) + 4] = __uint_as_float(rr[1]); }
#pragma unroll
            for (int i = 0; i < 4; ++i) { auto rr = __builtin_amdgcn_permlane32_swap(__float_as_uint(acc1[i]), __float_as_uint(acc1[i]), false, false); gl[i] = __uint_as_float(rr[0]); }
            float ss = 0.f;
#pragma unroll
            for (int q = 0; q < 4; ++q) { const f32x4 v = *(const GAS f32x4*)(ssqp + (size_t)row * 16 + 4 * q); ss += (v.x + v.y) + (v.z + v.w); }
            rs = 1.0f / sqrtf(ss * (1.f / DM) + EPS);
#pragma unroll
            for (int i = 0; i < 4; ++i) gl[i] = gl[i] * rs + bgroup[i];
            int g = 0; float gmx = gl[0];
#pragma unroll
            for (int i = 1; i < 4; ++i) { const bool b = gl[i] > gmx; gmx = b ? gl[i] : gmx; g = b ? i : g; }
            float Z = 0.f;
#pragma unroll
            for (int i = 0; i < 4; ++i) Z += __expf(gl[i] - gmx);
            const float pg = 1.0f / Z;
            float v[8];
#pragma unroll
            for (int j = 0; j < 8; ++j) { const float x = (g == 0) ? el[j] : (g == 1) ? el[8 + j] : (g == 2) ? el[16 + j] : el[24 + j]; v[j] = x * rs + brouter[g * 8 + j]; }
            int i1 = 0; float m1 = v[0];
#pragma unroll
            for (int j = 1; j < 8; ++j) { const bool b = v[j] > m1; m1 = b ? v[j] : m1; i1 = b ? j : i1; }
            int i2 = 0; float m2 = -INFINITY;
#pragma unroll
            for (int j = 0; j < 8; ++j) { const bool b = (j != i1) && (v[j] > m2); m2 = b ? v[j] : m2; i2 = b ? j : i2; }
            const float tt = __expf(m2 - m1); w1 = pg / (1.0f + tt); w2 = pg * tt / (1.0f + tt);
            e1 = g * 8 + i1; e2 = g * 8 + i2;
            if (hi == 0) { p1 = __hip_atomic_fetch_add(lcnt + e1, 1, __ATOMIC_RELAXED, __HIP_MEMORY_SCOPE_WORKGROUP); p2 = __hip_atomic_fetch_add(lcnt + e2, 1, __ATOMIC_RELAXED, __HIP_MEMORY_SCOPE_WORKGROUP); }
        }
        __syncthreads();
        if (tid < 32) lbase[tid] = (int)__hip_atomic_fetch_add(cnt + tid * 16, (unsigned)lcnt[tid], RLX_AGENT);
        __syncthreads();
        if (wave < 4 && hi == 0) {
            list[(size_t)e1 * LISTCAP + lbase[e1] + p1] = 2u * row; list[(size_t)e2 * LISTCAP + lbase[e2] + p2] = 2u * row + 1u;
            wgt[2 * row] = w1; wgt[2 * row + 1] = w2; rstd[row] = rs;
        }
        __syncthreads();
    }
}

__device__ __forceinline__ int moe_prefix(LAS unsigned char* lds, const Args& A, int tid) {
    LAS int* tpre = (LAS int*)(lds + LDSCTL_OFF); LAS int* cnts = (LAS int*)(lds + LDSCTL_OFF + 160);
    unsigned* cnt = (unsigned*)(A.ws + WS_CTL) + CW_CNT;
    __syncthreads();
    if (tid < 32) cnts[tid] = (int)__hip_atomic_load(cnt + tid * 16, RLX_AGENT);
    __syncthreads();
    if (tid == 0) { int s = 0; for (int e = 0; e < NEXP; ++e) { tpre[e] = s; s += (cnts[e] + 255) >> 8; } tpre[NEXP] = s; }
    __syncthreads();
    return tpre[NEXP];
}

__device__ __forceinline__ void p9_final(const Args& A, int vcu, int G, int tid) {
    const int lane = tid & 63, wave = __builtin_amdgcn_readfirstlane(tid >> 6);
    const int gw = vcu * NWAVES + wave, NGW = G * NWAVES;
    f32x4 gv[4];
#pragma unroll
    for (int j = 0; j < 4; ++j) gv[j] = ((const GAS f32x4*)A.in[19])[lane + 64 * j];
    const float* x1 = (const float*)(A.ws + WS_X1); const bf16* yc = (const bf16*)(A.ws + WS_YC);
    for (int m = gw; m < T; m += NGW) {
        const GAS f32x4* xr = (const GAS f32x4*)(x1 + (size_t)m * DM) + lane;
        const GAS u32x2* y0 = (const GAS u32x2*)(yc + (size_t)(2 * m) * DM) + lane; const GAS u32x2* y1 = (const GAS u32x2*)(yc + (size_t)(2 * m + 1) * DM) + lane;
        f32x4 v[4]; float s = 0.f;
#pragma unroll
        for (int j = 0; j < 4; ++j) { const u32x2 a = y0[64 * j], b = y1[64 * j]; v[j] = xr[64 * j];
            v[j].x += bf2f_lo(a.x) + bf2f_lo(b.x); v[j].y += bf2f_hi(a.x) + bf2f_hi(b.x); v[j].z += bf2f_lo(a.y) + bf2f_lo(b.y); v[j].w += bf2f_hi(a.y) + bf2f_hi(b.y);
            s += (v[j].x * v[j].x + v[j].y * v[j].y) + (v[j].z * v[j].z + v[j].w * v[j].w); }
        const float rstd = 1.0f / sqrtf(wave_sum(s) * (1.f / DM) + EPS);
        GAS f32x4* o = (GAS f32x4*)(A.out + (size_t)m * DM) + lane;
#pragma unroll
        for (int j = 0; j < 4; ++j) o[64 * j] = v[j] * rstd * gv[j];
    }
}

__global__ void __launch_bounds__(NWAVES * 64, 2) mk_fwd(Args args) {
    extern __shared__ __attribute__((aligned(16))) unsigned char lds[];
    LAS unsigned char* L = (LAS unsigned char*)lds;
    volatile LAS unsigned* MISC = (volatile LAS unsigned*)(L + MISC_OFF);
    const int tid = threadIdx.x;
    const int G = gridDim.x; const int bx = blockIdx.x; const int vcu = (G % 8 == 0) ? (bx % 8) * (G / 8) + bx / 8 : bx;
    unsigned char* ws = args.ws;
    gu32* ctl = (gu32*)(ws + WS_CTL);
    for (int u = tid; u < (LDS_BYTES - LDSCTL_OFF) / 4; u += NWAVES * 64) ((LAS unsigned*)(L + LDSCTL_OFF))[u] = 0u;
    __syncthreads();
    XcdBarrier bar; bar.bar = (unsigned*)(ctl + CW_BAR); bar.x = 0; bar.st = nullptr;
    if (N_LAUNCHES == 1) bar = xcd_barrier_post((unsigned*)(ctl + CW_BAR), MISC + 8);
    const int lo = args.ph_lo, hi = args.ph_hi;
#ifndef PH_MASK
#define PH_MASK 0x3ff
#endif
#define IN(k) (((PH_MASK >> (k)) & 1) && lo <= (k) && (k) < hi)
#define BOTH(k) (IN(k) && IN((k) + 1))
#define GRID_BAR() do { if (N_LAUNCHES == 1) xcd_barrier(bar); } while (0)

    if (IN(0)) { p0_prologue(L, args, vcu, G, tid); if (BOTH(0)) GRID_BAR(); }

    if (IN(1)) {
        pg8::Gemm g{(const pg8::bf16_t*)(ws + WS_H), (const pg8::bf16_t*)(ws + WS_WIN), T, INC, DM}; pg8::StaticOrder S; S.init(T, INC, G, bx);
        pg8::EpiProj E{(pg8::bf16_t*)(ws + WS_R6), (pg8::bf16_t*)(ws + WS_GATES), (const float*)(ws + WS_ROPE), (const float*)(ws + WS_ROPE) + SEQ * 32, (float*)(ws + WS_KPART)};
        pg8::gemm_phase<pg8::EpiProj, pg8::StaticOrder, true, false>(L + RING_OFF, g, S, E);
        if (BOTH(1)) GRID_BAR();
    }

    if (IN(2)) { p2_attention((char*)lds + RING_OFF, ws, vcu, G); if (BOTH(2)) GRID_BAR(); }

    if (IN(3)) { p3_combine(args, vcu, G, tid); if (BOTH(3)) GRID_BAR(); }

    if (IN(4)) {
        pg8::StaticOrder S; S.init(T, DM, G, bx);
        { pg8::Gemm g{(const pg8::bf16_t*)(ws + WS_OA), (const pg8::bf16_t*)(ws + WS_WBM), T, DM, 512};
          pg8::EpiMerge<0> E{(pg8::bf16_t*)(ws + WS_MERGED), (const pg8::bf16_t*)(ws + WS_GATES)};
          pg8::gemm_phase<pg8::EpiMerge<0>, pg8::StaticOrder, true, false>(L + RING_OFF, g, S, E); }
        { pg8::Gemm g{(const pg8::bf16_t*)(ws + WS_ODF), (const pg8::bf16_t*)(ws + WS_WBD), T, DM, 512};
          pg8::EpiMerge<1> E{(pg8::bf16_t*)(ws + WS_MERGED), (const pg8::bf16_t*)(ws + WS_GATES)};
          pg8::gemm_phase<pg8::EpiMerge<1>, pg8::StaticOrder, true, false>(L + RING_OFF, g, S, E); }
        if (BOTH(4)) GRID_BAR();
    }

    if (IN(5)) {
        pg8::Gemm g{(const pg8::bf16_t*)(ws + WS_MERGED), (const pg8::bf16_t*)(ws + WS_WOUT), T, DM, DM}; pg8::StaticOrder S; S.init(T, DM, G, bx);
        pg8::EpiRes E{args.in[0], (float*)(ws + WS_X1), (pg8::bf16_t*)(ws + WS_H), args.in[11], (float*)(ws + WS_SSQP)};
        pg8::gemm_phase<pg8::EpiRes, pg8::StaticOrder, true, false>(L + RING_OFF, g, S, E);
        if (BOTH(5)) GRID_BAR();
    }

    if (IN(6)) { p6_router(L + RING_OFF, args, vcu, G, tid); if (BOTH(6)) GRID_BAR(); }

    if (IN(7)) {
        const int ntile = moe_prefix(L, args, tid);
        pg8::Gemm g{(const pg8::bf16_t*)(ws + WS_H), (const pg8::bf16_t*)(ws + WS_W13), T, 1024, DM};
        pg8::MoeOrder S{(const LAS int*)(L + LDSCTL_OFF), (const LAS int*)(L + LDSCTL_OFF + 160), (const unsigned*)(ws + WS_LIST), G, bx, 4 * ntile, 1, 2048u};
        pg8::EpiAct E{(pg8::bf16_t*)(ws + WS_ACT), (const unsigned*)(ws + WS_LIST), (const float*)(ws + WS_RSTD)};
        pg8::gemm_phase<pg8::EpiAct, pg8::MoeOrder, true, true>(L + RING_OFF, g, S, E);
        if (BOTH(7)) GRID_BAR();
    }

    if (IN(8)) {
        const int ntile = moe_prefix(L, args, tid);
        pg8::Gemm g{(const pg8::bf16_t*)(ws + WS_ACT), (const pg8::bf16_t*)(ws + WS_W2), 2 * T, 1024, 512};
        pg8::MoeOrder S{(const LAS int*)(L + LDSCTL_OFF), (const LAS int*)(L + LDSCTL_OFF + 160), (const unsigned*)(ws + WS_LIST), G, bx, 4 * ntile, 0, 1024u};
        pg8::EpiDown E{(pg8::bf16_t*)(ws + WS_YC), (const unsigned*)(ws + WS_LIST), (const float*)(ws + WS_WGT)};
        pg8::gemm_phase<pg8::EpiDown, pg8::MoeOrder, true, true>(L + RING_OFF, g, S, E);
        if (BOTH(8)) GRID_BAR();
    }

    if (IN(9)) { p9_final(args, vcu, G, tid); }
#undef IN
#undef BOTH
#undef GRID_BAR
}

extern "C" void kernel_launch(void* const* d_in, const int* in_sizes, int n_in, void* d_out, int out_size, void* d_ws, size_t ws_size, hipStream_t stream) {
    static int grid = 0;
    if (grid == 0) {
        if (n_in != 20 || in_sizes[0] != T * DM || out_size != T * DM || ws_size < WS_END) { fprintf(stderr, "kernel_launch: built for 20 inputs, x/out of %d floats, >= %zu bytes of workspace; got n_in %d, in0 %d, out %d, ws %zu; nothing launched\n", T * DM, (size_t)WS_END, n_in, n_in > 0 ? in_sizes[0] : -1, out_size, ws_size); grid = -1; return; }
        int dev = 0, cus = 0, per_cu = 0;
        if (hipGetDevice(&dev) != hipSuccess || hipDeviceGetAttribute(&cus, hipDeviceAttributeMultiprocessorCount, dev) != hipSuccess) { fprintf(stderr, "kernel_launch: hipGetDevice / hipDeviceGetAttribute failed; nothing launched\n"); grid = -1; return; }
        if (hipFuncSetAttribute((const void*)mk_fwd, hipFuncAttributeMaxDynamicSharedMemorySize, LDS_BYTES) != hipSuccess) { fprintf(stderr, "kernel_launch: hipFuncSetAttribute failed; nothing launched\n"); grid = -1; return; }
        if (hipOccupancyMaxActiveBlocksPerMultiprocessor(&per_cu, (const void*)mk_fwd, NWAVES * 64, LDS_BYTES) != hipSuccess || per_cu < 1)
            fprintf(stderr, "kernel_launch: note: the occupancy query reports %d workgroups per CU\n", per_cu);
        (void)hipGetLastError();
        grid = cus;
    }
    if (grid < 0) return;
    if (hipMemsetAsync((char*)d_ws + WS_CTL, 0, CTL_ZERO_BYTES, stream) != hipSuccess) { fprintf(stderr, "kernel_launch: hipMemsetAsync of the control words failed; nothing launched\n"); return; }
    Args a{};
    for (int i = 0; i < 20; ++i) a.in[i] = (const float*)d_in[i];
    a.out = (float*)d_out; a.ws = (unsigned char*)d_ws;
    for (int li = 0; li < N_LAUNCHES; ++li) {
        a.ph_lo = (N_LAUNCHES == 1) ? 0 : li; a.ph_hi = (N_LAUNCHES == 1) ? N_PHASES : li + 1;
        hipLaunchKernelGGL(mk_fwd, dim3(grid), dim3(NWAVES * 64), LDS_BYTES, stream, a);
        const hipError_t le = hipPeekAtLastError();
        if (le != hipSuccess) { fprintf(stderr, "kernel_launch: launch %d failed: %s\n", li, hipGetErrorName(le)); break; }
    }
}
```

```cpp
#include <hip/hip_runtime.h>
#include <hip/hip_bf16.h>
#include <cstdio>
#include <cstdint>
#include <cmath>

#ifndef MK_N_LAUNCHES
#define MK_N_LAUNCHES 1
#endif

constexpr int BATCH = 16, SEQ = 2048, T = BATCH * SEQ, DM = 1024, INC = 5120;
constexpr int NEXP = 32, DEXP = 512, LISTCAP = 32768;
constexpr float EPS = 1e-6f;
constexpr float C2 = 0.125f * 1.4426950408889634f;

namespace pg8 {
#define PG8_LAS __attribute__((address_space(3)))
typedef unsigned short bf16_t;
typedef short bf16x8 __attribute__((ext_vector_type(8)));
typedef float f32x4 __attribute__((ext_vector_type(4)));
typedef unsigned u32x4 __attribute__((ext_vector_type(4)));
typedef int i32x4 __attribute__((ext_vector_type(4)));
typedef unsigned u32x2 __attribute__((ext_vector_type(2)));
constexpr int BM = 256, BK = 64, HALF = 128, HTB = HALF * BK * 2  , STAGE_BYTES = 8 * HTB, NXCD = 8, WGM = 8;

__host__ __device__ __forceinline__ int lds_byte(int r, int c) { const int st = (r >> 4) * 2 + (c >> 5), rr = r & 15, cc = c & 31, ob = rr * 64 + cc * 2; return st * 1024 + (ob ^ (((ob >> 9) & 1) << 5)); }
__host__ __device__ __forceinline__ void stage_rc(int b, int& R, int& C) { const int st = b / 1024, sb = b % 1024, swz = sb ^ (((sb >> 9) & 1) << 5); R = (st >> 1) * 16 + swz / 64; C = (st & 1) * 32 + (swz % 64) / 2; }
__host__ __device__ __forceinline__ int permB(int R) { return 64 * ((R >> 5) & 3) + 16 * ((R & 15) >> 2) + 4 * ((R >> 4) & 1) + (R & 3); }
__host__ __device__ __forceinline__ int perm32(int rho) { const int n = rho >> 4, i = rho & 15; return 8 * (i >> 2) + 4 * n + (i & 3); }

struct Unit { int pm, pn, e, ti, cnt; };
struct Gemm { const bf16_t* A; const bf16_t* Bt; int M, N, K; const bf16_t* A2; const bf16_t* Bt2; int wscale; };

struct StaticOrder {
    int nM, nN, nwg, G, c;
    __host__ __device__ void init(int M, int N, int G_, int c_) { nM = M / BM; nN = N / BM; nwg = nM * nN; G = G_; c = c_; }
    __host__ __device__ bool next(int i, Unit& u) const {
        const long L = (long)i * G + c; if (L >= nwg) return false;
        int wgid = (int)L; { const int q = nwg / NXCD, r = nwg % NXCD, xcd = wgid % NXCD, off = wgid / NXCD; wgid = (xcd < r ? xcd * (q + 1) : r * (q + 1) + (xcd - r) * q) + off; }
        const int nig = WGM * nN, gid = wgid / nig, fm = gid * WGM, gsz = (nM - fm) < WGM ? (nM - fm) : WGM;
        u.pm = fm + ((wgid % nig) % gsz); u.pn = (wgid % nig) / gsz; u.e = 0; u.ti = 0; u.cnt = 0; return true;
    }
    __device__ __forceinline__ unsigned arow(const Unit&, int) const { return 0u; }
    __device__ __forceinline__ void a_ready(const Unit&) const {}
    __device__ __forceinline__ void done(const Unit&) const {}
};

#ifndef P1_NBF
#define P1_NBF 6
#endif
constexpr int P1_NB = P1_NBF;
template <int MODE> struct SubOrder {
    StaticOrder S;
    __device__ void init(int M, int G_, int c_) { S.init(M, (MODE == 0 ? P1_NB : 20 - P1_NB) * BM, G_, c_); }
    __device__ bool next(int i, Unit& u) const { if (!S.next(i, u)) return false; u.pn = (MODE == 0) ? u.pn + 6 : (u.pn < 6 ? u.pn : u.pn + P1_NB); return true; }
    __device__ __forceinline__ unsigned arow(const Unit&, int) const { return 0u; }
    __device__ __forceinline__ void a_ready(const Unit&) const {}
    __device__ __forceinline__ void done(const Unit&) const {}
};

typedef float f32x2 __attribute__((ext_vector_type(2))); typedef __bf16 bf16x2v __attribute__((ext_vector_type(2)));
__device__ __forceinline__ unsigned cvt_pk_bf16(float lo, float hi) { f32x2 v = {lo, hi}; bf16x2v b = __builtin_convertvector(v, bf16x2v); return __builtin_bit_cast(unsigned, b); }
__device__ __forceinline__ u32x4 pack8(const f32x4 a, const f32x4 b) { u32x4 w; w.x = cvt_pk_bf16(a[0], a[1]); w.y = cvt_pk_bf16(a[2], a[3]); w.z = cvt_pk_bf16(b[0], b[1]); w.w = cvt_pk_bf16(b[2], b[3]); return w; }
__device__ __forceinline__ u32x2 pack8_fp8(const f32x4 a, const f32x4 b) { int lo = 0, hi = 0; lo = __builtin_amdgcn_cvt_pk_fp8_f32(a[0], a[1], lo, false); lo = __builtin_amdgcn_cvt_pk_fp8_f32(a[2], a[3], lo, true);
    hi = __builtin_amdgcn_cvt_pk_fp8_f32(b[0], b[1], hi, false); hi = __builtin_amdgcn_cvt_pk_fp8_f32(b[2], b[3], hi, true); return (u32x2){(unsigned)lo, (unsigned)hi}; }
__device__ __forceinline__ float bflo(unsigned w) { return __builtin_bit_cast(float, w << 16); }
__device__ __forceinline__ float bfhi(unsigned w) { return __builtin_bit_cast(float, w & 0xffff0000u); }
__device__ __forceinline__ void unpack8(const u32x4 w, f32x4& a, f32x4& b) { a = (f32x4){bflo(w.x), bfhi(w.x), bflo(w.y), bfhi(w.y)}; b = (f32x4){bflo(w.z), bfhi(w.z), bflo(w.w), bfhi(w.w)}; }
__device__ __forceinline__ float sigmoidf_(float x) { return __builtin_amdgcn_rcpf(1.0f + __builtin_amdgcn_exp2f(-1.4426950408889634f * x)); }

template <class Epi, class Sched, bool ALIGN_EPI, bool GATHER, bool DUAL = false, bool FP8 = false>
__device__ __forceinline__ void gemm_phase(PG8_LAS unsigned char* lds, const Gemm g, const Sched& S, const Epi& E) {
    const int tid = threadIdx.x, wid = __builtin_amdgcn_readfirstlane(tid >> 6), lane = tid & 63, wr = wid >> 2, wc = wid & 3, fr = lane & 15, fq = lane >> 4;
    const int wscale = g.wscale, ascale = 0x7f7f7f7f;
    const int K = g.K, nt = DUAL ? 2 * (K / BK) : K / BK, nth = K / BK;
    unsigned voffA[2], voffB[2]; int rowA[2]; unsigned colA[2];
#pragma unroll
    for (int i = 0; i < 2; ++i) { int R, C; stage_rc(tid * 16 + i * 8192, R, C); const int Rb = permB(R);
        voffA[i] = (unsigned)(R * K + C) * 2u; voffB[i] = (unsigned)(Rb * K + C) * 2u; rowA[i] = R; colA[i] = (unsigned)C * 2u; }
    const size_t kstep = (size_t)(BK * 2);
    const size_t hstep = (size_t)HALF * K * 2;
    const size_t hstepB = (size_t)8 * K * 2;
    const size_t tstep = 2 * hstep;
    const unsigned ldsw = (unsigned)wid * 1024u;
    const int aoff = lds_byte(wr * 64 + fr, fq * 8), boff = lds_byte(wc * 32 + fr, fq * 8);
#define PG8_SA(b, h) (((b) * 2 + (h)) * HTB)
#define PG8_SB(b, h) ((4 + (b) * 2 + (h)) * HTB)
#define PG8_STAGE(bufoff, gbase, voff) do { _Pragma("unroll") for (int _i = 0; _i < 2; ++_i) \
        __builtin_amdgcn_global_load_lds((const unsigned*)((const char*)(gbase) + (voff)[_i]), (PG8_LAS unsigned*)(lds + (bufoff) + ldsw + _i * 8192), 16, 0, 0); } while (0)
#define PG8_STAGE_A(bufoff, ptr, H, ARR0, ARR1) do { if constexpr (GATHER) { if (H) PG8_STAGE(bufoff, ptr, ARR1); else PG8_STAGE(bufoff, ptr, ARR0); } else { PG8_STAGE(bufoff, (ptr) + (H) * hstep, voffA); } } while (0)
#define PG8_LDA(dst, b, h) do { _Pragma("unroll") for (int m = 0; m < 4; ++m) _Pragma("unroll") for (int k = 0; k < 2; ++k) dst[m][k] = *(const PG8_LAS bf16x8*)(lds + PG8_SA(b, h) + aoff + m * 2048 + k * 1024); } while (0)
#define PG8_LDB(dst, b, h) do { _Pragma("unroll") for (int n = 0; n < 2; ++n) _Pragma("unroll") for (int k = 0; k < 2; ++k) dst[n][k] = *(const PG8_LAS bf16x8*)(lds + PG8_SB(b, h) + boff + n * 2048 + k * 1024); } while (0)
#define PG8_CAT(x) __builtin_shufflevector(__builtin_bit_cast(i32x4, (x)[0]), __builtin_bit_cast(i32x4, (x)[1]), 0, 1, 2, 3, 4, 5, 6, 7)
#define PG8_MMA(ai, bj, At, Bt) do { __builtin_amdgcn_s_setprio(1); if constexpr (FP8) { _Pragma("unroll") for (int m = 0; m < 4; ++m) _Pragma("unroll") for (int n = 0; n < 2; ++n) \
        asm volatile("v_mfma_scale_f32_16x16x128_f8f6f4 %0, %1, %2, %0, %3, %4 op_sel_hi:[0,0,0]" : "+v"(acc[ai][bj][m][n]) : "v"(PG8_CAT(Bt[n])), "v"(PG8_CAT(At[m])), "v"(wscale), "v"(ascale)); } \
        else { _Pragma("unroll") for (int m = 0; m < 4; ++m) _Pragma("unroll") for (int n = 0; n < 2; ++n) _Pragma("unroll") for (int k = 0; k < 2; ++k) \
        acc[ai][bj][m][n] = __builtin_amdgcn_mfma_f32_16x16x32_bf16(Bt[n][k], At[m][k], acc[ai][bj][m][n], 0, 0, 0); } __builtin_amdgcn_s_setprio(0); } while (0)
#define PG8_WAIT_V(n) asm volatile("s_waitcnt vmcnt(" #n ")" ::: "memory")
#define PG8_WAIT_L(n) asm volatile("s_waitcnt lgkmcnt(" #n ")" ::: "memory")
#define PG8_BAR __builtin_amdgcn_s_barrier()
#define PG8_SCHED __builtin_amdgcn_sched_barrier(0)
    Unit cur, nxt; int ui = 0;
    if (!S.next(0, cur)) return;
    f32x4 acc[2][2][4][2];
#define PG8_ZERO_ACC() do { _Pragma("unroll") for (int a = 0; a < 2; ++a) _Pragma("unroll") for (int b = 0; b < 2; ++b) _Pragma("unroll") for (int m = 0; m < 4; ++m) _Pragma("unroll") for (int n = 0; n < 2; ++n) { \
        f32x2 lo_, hi_; asm volatile("v_mov_b64 %0, 0" : "=v"(lo_)); asm volatile("v_mov_b64 %0, 0" : "=v"(hi_)); acc[a][b][m][n] = __builtin_shufflevector(lo_, hi_, 0, 1, 2, 3); } } while (0)
    PG8_ZERO_ACC();
    bf16x8 At[4][2], B0[2][2], B1[2][2];
    float ef[8];
    unsigned ea[8];
    unsigned v0[2] = {0u, 0u}, v1[2] = {0u, 0u}, nv0[2] = {0u, 0u}, nv1[2] = {0u, 0u};
    const char* cA = GATHER ? (const char*)g.A : (const char*)g.A + (size_t)cur.pm * tstep; const char* cB = (const char*)g.Bt + (size_t)cur.pn * tstep;
    const char* cA2 = DUAL ? (const char*)g.A2 + (size_t)cur.pm * tstep : cA; const char* cB2 = DUAL ? (const char*)g.Bt2 + (size_t)cur.pn * tstep : cB;
#define PG8_KT(a, a2, j) ((DUAL && (j) >= nth) ? (a2) + (size_t)((j) - nth) * kstep : (a) + (size_t)(j) * kstep)
    if constexpr (GATHER) {
#pragma unroll
        for (int i = 0; i < 2; ++i) { v0[i] = S.arow(cur, rowA[i]) + colA[i]; v1[i] = S.arow(cur, HALF + rowA[i]) + colA[i]; }
    }
    S.a_ready(cur);
    PG8_STAGE(PG8_SB(0, 0), cB, voffB); PG8_STAGE(PG8_SB(0, 1), cB + hstepB, voffB); PG8_STAGE_A(PG8_SA(0, 0), cA, 0, v0, v1); PG8_STAGE_A(PG8_SA(0, 1), cA, 1, v0, v1);
    if (wr == 1) PG8_BAR;
    PG8_WAIT_V(2); PG8_BAR;
    PG8_STAGE(PG8_SB(1, 0), cB + kstep, voffB); PG8_STAGE_A(PG8_SA(1, 0), cA + kstep, 0, v0, v1); PG8_STAGE(PG8_SB(1, 1), cB + hstepB + kstep, voffB);
    PG8_WAIT_V(6); PG8_BAR;
    for (;;) {
        const bool has_next = S.next(ui + 1, nxt);
        const char* nA = GATHER ? cA : (has_next ? (const char*)g.A + (size_t)nxt.pm * tstep : cA); const char* nB = has_next ? (const char*)g.Bt + (size_t)nxt.pn * tstep : cB;
        if constexpr (GATHER) {
            if (has_next) {
#pragma unroll
                for (int i = 0; i < 2; ++i) { nv0[i] = S.arow(nxt, rowA[i]) + colA[i]; nv1[i] = S.arow(nxt, HALF + rowA[i]) + colA[i]; }
            } else {
#pragma unroll
                for (int i = 0; i < 2; ++i) { nv0[i] = v0[i]; nv1[i] = v1[i]; }
            }
        }
        if constexpr (GATHER) E.prefetch(cur, wr, fr, ea, ef);
#pragma nounroll
        for (int t = 0; t < nt; t += 2) {
            const bool last = (t == nt - 2);
            const char* a1 = PG8_KT(cA, cA2, t + 1);
            const char* a2 = last ? nA : PG8_KT(cA, cA2, t + 2); const char* b2 = last ? nB : PG8_KT(cB, cB2, t + 2);
            const char* a3 = a2 + kstep; const char* b3 = b2 + kstep;
            unsigned w0[2], w1[2];
#pragma unroll
            for (int i = 0; i < 2; ++i) { w0[i] = last ? nv0[i] : v0[i]; w1[i] = last ? nv1[i] : v1[i]; }
            if (last && has_next) S.a_ready(nxt);
            if constexpr (DUAL) { if (t == nth) E.mid(acc, cur, wr, wc, fr, fq); }
            PG8_LDB(B0, 0, 0); PG8_LDB(B1, 0, 1); PG8_SCHED; PG8_LDA(At, 0, 0); PG8_STAGE_A(PG8_SA(1, 1), a1, 1, v0, v1);
            PG8_WAIT_V(8); PG8_WAIT_L(0); PG8_BAR; PG8_MMA(0, 0, At, B0); PG8_MMA(0, 1, At, B1); PG8_BAR; PG8_SCHED;
            PG8_LDA(At, 0, 1); PG8_STAGE(PG8_SB(0, 0), b2, voffB); PG8_STAGE(PG8_SB(0, 1), b2 + hstepB, voffB); PG8_STAGE_A(PG8_SA(0, 0), a2, 0, w0, w1);
            PG8_WAIT_V(8); PG8_WAIT_L(0); PG8_BAR; PG8_MMA(1, 0, At, B0); PG8_MMA(1, 1, At, B1); PG8_BAR; PG8_SCHED;
            PG8_LDB(B0, 1, 0); PG8_LDB(B1, 1, 1); PG8_SCHED; PG8_LDA(At, 1, 0); PG8_STAGE_A(PG8_SA(0, 1), a2, 1, w0, w1);
            PG8_WAIT_V(8); PG8_WAIT_L(0); PG8_BAR; PG8_MMA(0, 0, At, B0); PG8_MMA(0, 1, At, B1); PG8_BAR; PG8_SCHED;
            PG8_LDA(At, 1, 1); PG8_STAGE(PG8_SB(1, 0), b3, voffB); PG8_STAGE(PG8_SB(1, 1), b3 + hstepB, voffB); PG8_STAGE_A(PG8_SA(1, 0), a3, 0, w0, w1);
            PG8_WAIT_V(8); PG8_WAIT_L(0); PG8_BAR; PG8_MMA(1, 0, At, B0); PG8_MMA(1, 1, At, B1); PG8_BAR; PG8_SCHED;
        }
        if constexpr (ALIGN_EPI) { if (wr == 0) PG8_BAR; }
        if constexpr (FP8) asm volatile("s_nop 15\n\ts_nop 7" ::: "memory");
        if constexpr (GATHER) E(acc, cur, wr, wc, fr, fq, ea, ef); else E(acc, cur, wr, wc, fr, fq);
        S.done(cur);
        if (!has_next) break;
        PG8_ZERO_ACC();
        cur = nxt; cA = nA; cB = nB; ++ui;
        if constexpr (DUAL) { cA2 = (const char*)g.A2 + (size_t)cur.pm * tstep; cB2 = (const char*)g.Bt2 + (size_t)cur.pn * tstep; }
        if constexpr (GATHER) {
#pragma unroll
            for (int i = 0; i < 2; ++i) { v0[i] = nv0[i]; v1[i] = nv1[i]; }
        }
        if constexpr (ALIGN_EPI) { if (wr == 1) PG8_BAR; }
    }
    PG8_WAIT_V(0);
    if constexpr (!ALIGN_EPI) { if (wr == 0) PG8_BAR; }
    PG8_BAR;
#undef PG8_KT
#undef PG8_SA
#undef PG8_SB
#undef PG8_STAGE
#undef PG8_STAGE_A
#undef PG8_LDA
#undef PG8_LDB
#undef PG8_MMA
#undef PG8_ZERO_ACC
#undef PG8_CAT
#undef PG8_WAIT_V
#undef PG8_WAIT_L
#undef PG8_BAR
#undef PG8_SCHED
}

#define EPI_ROWLOOP _Pragma("unroll") for (int ai = 0; ai < 2; ++ai) _Pragma("unroll") for (int m = 0; m < 4; ++m)

struct EpiProj {
    bf16_t* reg6;
    bf16_t* gates;
    const float* cosT; const float* sinT;
    float* kpart;
    __device__ __forceinline__ void operator()(const f32x4 (&acc)[2][2][4][2], const Unit& u, int wr, int wc, int fr, int fq) const {
        const int pn = u.pn, row0 = u.pm * BM + wr * 64 + fr;
        if (pn >= 12) {
            const int col0 = (pn - 12) * 256 + wc * 64 + 16 * fq; const bool br1 = pn >= 16;
            unsigned char* g8 = (unsigned char*)gates;
            EPI_ROWLOOP { unsigned char* rowp = g8 + (size_t)(row0 + ai * HALF + m * 16) * 2048 + col0; u32x4 w;
#pragma unroll
                for (int bj = 0; bj < 2; ++bj) { const f32x4 a = acc[ai][bj][m][0], b = acc[ai][bj][m][1]; unsigned lo = 0u, hi = 0u;
#pragma unroll
                    for (int i = 0; i < 4; ++i) { float da = __builtin_fmaf(__builtin_amdgcn_exp2f(a[i]), 1.0f / 255.0f, 1.0f / 255.0f), db = __builtin_fmaf(__builtin_amdgcn_exp2f(b[i]), 1.0f / 255.0f, 1.0f / 255.0f);
                        if (br1) { da = __builtin_fminf(__builtin_fmaxf(da, 0.0f), 1.0f); db = __builtin_fminf(__builtin_fmaxf(db, 0.0f), 1.0f); }
                        lo = __builtin_amdgcn_cvt_pk_u8_f32(__builtin_amdgcn_rcpf(da), i, lo); hi = __builtin_amdgcn_cvt_pk_u8_f32(__builtin_amdgcn_rcpf(db), i, hi); }
                    w[2 * bj] = lo; w[2 * bj + 1] = hi; }
                __builtin_nontemporal_store(w, (u32x4*)rowp); }
            return;
        }
        const int rg = pn >> 1, pl = pn & 1;
        bf16_t* dst = reg6 + (size_t)rg * ((size_t)T * 512);
        if (rg == 2 || rg == 5) {
            const int col0 = pl * 256 + wc * 64 + 16 * fq;
            EPI_ROWLOOP { bf16_t* rowp = dst + (size_t)(row0 + ai * HALF + m * 16) * 512 + col0;
#pragma unroll
                for (int bj = 0; bj < 2; ++bj) *(u32x4*)(rowp + bj * 8) = pack8(acc[ai][bj][m][0], acc[ai][bj][m][1]); }
            return;
        }
        const float sc = (rg == 0 || rg == 3) ? C2 : 1.0f;
        const int col0 = (pl * 4 + wc) * 64 + 8 * fq;
        f32x4 ks[4] = {{0.f, 0.f, 0.f, 0.f}, {0.f, 0.f, 0.f, 0.f}, {0.f, 0.f, 0.f, 0.f}, {0.f, 0.f, 0.f, 0.f}};
#pragma unroll
        for (int aim = 0; aim < 8; aim += 2) {
        f32x4 tc0[2], tc1[2], ts0[2], ts1[2];
#pragma unroll
        for (int q = 0; q < 2; ++q) { const int s = (row0 + ((aim + q) >> 2) * HALF + ((aim + q) & 3) * 16) & (SEQ - 1);
            tc0[q] = *(const f32x4*)(cosT + s * 32 + 8 * fq); tc1[q] = *(const f32x4*)(cosT + s * 32 + 8 * fq + 4); ts0[q] = *(const f32x4*)(sinT + s * 32 + 8 * fq); ts1[q] = *(const f32x4*)(sinT + s * 32 + 8 * fq + 4); }
#pragma unroll
        for (int q = 0; q < 2; ++q) { const int ai = (aim + q) >> 2, m = (aim + q) & 3, row = row0 + ai * HALF + m * 16;
            const f32x4 c0 = tc0[q], c1 = tc1[q], s0 = ts0[q], s1 = ts1[q];
            const f32x4 x1a = acc[ai][0][m][0], x1b = acc[ai][0][m][1], x2a = acc[ai][1][m][0], x2b = acc[ai][1][m][1];
            const f32x4 o1a = x1a * c0 - x2a * s0, o1b = x1b * c1 - x2b * s1, o2a = x2a * c0 + x1a * s0, o2b = x2b * c1 + x1b * s1;
            if (rg == 1) { ks[0] += o1a; ks[1] += o1b; ks[2] += o2a; ks[3] += o2b; }
            bf16_t* rowp = dst + (size_t)row * 512 + col0;
            *(u32x4*)(rowp) = pack8(o1a * sc, o1b * sc); *(u32x4*)(rowp + 32) = pack8(o2a * sc, o2b * sc); }
        }
        if (rg == 1) {
#pragma unroll
            for (int q = 0; q < 4; ++q)
#pragma unroll
                for (int i = 0; i < 4; ++i) { float v = ks[q][i]; v += __shfl_xor(v, 1); v += __shfl_xor(v, 2); v += __shfl_xor(v, 4); v += __shfl_xor(v, 8); ks[q][i] = v; }
            if (fr == 0) { const int b = u.pm >> 3, blk = u.pm & 7, h = pl * 4 + wc;
                float* kp = kpart + ((((size_t)wr * 16 + b) * 8 + h) * 8 + blk) * 64 + 8 * fq;
                *(f32x4*)(kp) = ks[0]; *(f32x4*)(kp + 4) = ks[1]; *(f32x4*)(kp + 32) = ks[2]; *(f32x4*)(kp + 36) = ks[3]; }
        }
    }
};

struct EpiMerge2 {
    bf16_t* merged; const bf16_t* gates;
    static __device__ __forceinline__ float ub(unsigned w, int i) { return (float)((w >> (8 * i)) & 0xffu); }
    __device__ __forceinline__ void mid(f32x4 (&acc)[2][2][4][2], const Unit& u, int wr, int wc, int fr, int fq) const {
        const int row0 = u.pm * BM + wr * 64 + fr, col0 = u.pn * BM + wc * 64 + 16 * fq; const unsigned char* g8 = (const unsigned char*)gates;
        EPI_ROWLOOP { const int row = row0 + ai * HALF + m * 16; const unsigned char* gp = g8 + (size_t)row * 2048 + col0;
            const u32x4 w0 = *(const u32x4*)gp, w1 = *(const u32x4*)(gp + 1024);
#pragma unroll
            for (int bj = 0; bj < 2; ++bj)
#pragma unroll
                for (int i = 0; i < 4; ++i) { acc[ai][bj][m][0][i] *= ub(w0[2 * bj], i) * __builtin_amdgcn_rcpf(ub(w1[2 * bj], i)); acc[ai][bj][m][1][i] *= ub(w0[2 * bj + 1], i) * __builtin_amdgcn_rcpf(ub(w1[2 * bj + 1], i)); } }
    }
    __device__ __forceinline__ void operator()(const f32x4 (&acc)[2][2][4][2], const Unit& u, int wr, int wc, int fr, int fq) const {
        const int row0 = u.pm * BM + wr * 64 + fr, col0 = u.pn * BM + wc * 64 + 16 * fq; const unsigned char* g8 = (const unsigned char*)gates;
        EPI_ROWLOOP { const int row = row0 + ai * HALF + m * 16;
            const u32x4 w1 = *(const u32x4*)(g8 + (size_t)row * 2048 + 1024 + col0);
#pragma unroll
            for (int bj = 0; bj < 2; ++bj) { f32x4 ga, gb;
#pragma unroll
                for (int i = 0; i < 4; ++i) { ga[i] = ub(w1[2 * bj], i) * (1.0f / 255.0f); gb[i] = ub(w1[2 * bj + 1], i) * (1.0f / 255.0f); }
                *(u32x4*)(merged + (size_t)row * 1024 + col0 + 8 * bj) = pack8(acc[ai][bj][m][0] * ga, acc[ai][bj][m][1] * gb); } }
    }
};

template <int PASS> struct EpiMerge {
    bf16_t* merged; const bf16_t* gates;
    __device__ __forceinline__ void operator()(const f32x4 (&acc)[2][2][4][2], const Unit& u, int wr, int wc, int fr, int fq) const {
        const int row0 = u.pm * BM + wr * 64 + fr, col0 = u.pn * BM + wc * 32 + 8 * fq;
        EPI_ROWLOOP { const int row = row0 + ai * HALF + m * 16;
#pragma unroll
            for (int bj = 0; bj < 2; ++bj) { const int col = col0 + bj * HALF;
                f32x4 ga, gb; unpack8(*(const u32x4*)(gates + (size_t)row * 2048 + PASS * 1024 + col), ga, gb);
                f32x4 a = acc[ai][bj][m][0] * ga, b = acc[ai][bj][m][1] * gb;
                bf16_t* mp = merged + (size_t)row * 1024 + col;
                if (PASS == 1) { f32x4 pa, pb; unpack8(*(const u32x4*)mp, pa, pb); a += pa; b += pb; }
                *(u32x4*)mp = pack8(a, b); } }
    }
};

struct EpiRes {
    const float* x; bf16_t* x1b; float* ssqp; unsigned char* x1f8;
    __device__ __forceinline__ void operator()(const f32x4 (&acc)[2][2][4][2], const Unit& u, int wr, int wc, int fr, int fq) const {
        const int row0 = u.pm * BM + wr * 64 + fr, col0 = u.pn * BM + wc * 64 + 16 * fq;
#pragma unroll
        for (int ai = 0; ai < 2; ++ai) {
            f32x4 xa[4][2], xb[4][2];
#pragma unroll
            for (int m = 0; m < 4; ++m)
#pragma unroll
                for (int bj = 0; bj < 2; ++bj) { const size_t off = (size_t)(row0 + ai * HALF + m * 16) * 1024 + col0 + bj * 8; xa[m][bj] = *(const f32x4*)(x + off); xb[m][bj] = *(const f32x4*)(x + off + 4); }
#pragma unroll
            for (int m = 0; m < 4; ++m) { const int row = row0 + ai * HALF + m * 16; float ss = 0.f; u32x4 w8;
#pragma unroll
                for (int bj = 0; bj < 2; ++bj) { const size_t off = (size_t)row * 1024 + col0 + bj * 8;
                    const f32x4 a = acc[ai][bj][m][0] + xa[m][bj], b = acc[ai][bj][m][1] + xb[m][bj];
                    ss += (a[0] * a[0] + a[1] * a[1]) + (a[2] * a[2] + a[3] * a[3]) + (b[0] * b[0] + b[1] * b[1]) + (b[2] * b[2] + b[3] * b[3]);
                    *(u32x4*)(x1b + off) = pack8(a, b); const u32x2 p = pack8_fp8(a, b); w8[2 * bj] = p.x; w8[2 * bj + 1] = p.y; }
                *(u32x4*)(x1f8 + (size_t)row * 1024 + col0) = w8;
                ss += __shfl_xor(ss, 16); ss += __shfl_xor(ss, 32);
                if (fq == 0) ssqp[(size_t)row * 16 + u.pn * 4 + wc] = ss; }
        }
    }
};

struct EpiNull {
    float* sink;
    __device__ __forceinline__ void operator()(const f32x4 (&acc)[2][2][4][2], const Unit& u, int wr, int wc, int fr, int fq) const {
        f32x4 s = {0.f, 0.f, 0.f, 0.f};
        EPI_ROWLOOP {
#pragma unroll
            for (int bj = 0; bj < 2; ++bj) s += acc[ai][bj][m][0] + acc[ai][bj][m][1]; }
        if (s[0] + s[1] + s[2] + s[3] == 12345.678f) sink[u.pm] = s[0];
    }
};

struct EpiAct {
    unsigned char* act; const unsigned* list;
    __device__ __forceinline__ void prefetch(const Unit& u, int wr, int fr, unsigned (&ea)[8], float (&ef)[8]) const {
        EPI_ROWLOOP { const int idx = u.ti * 256 + ai * HALF + wr * 64 + m * 16 + fr; const bool ok = idx < u.cnt;
            const unsigned* rp = list + ((size_t)u.e * LISTCAP + (ok ? idx : 0)) * 4; const unsigned a = rp[0]; ea[ai * 4 + m] = ok ? a : 0xffffffffu; ef[ai * 4 + m] = __builtin_bit_cast(float, rp[2]); }
    }
    __device__ __forceinline__ void operator()(const f32x4 (&acc)[2][2][4][2], const Unit& u, int wr, int wc, int fr, int fq, const unsigned (&ea)[8], const float (&rsv)[8]) const {
        const int pnl = u.pn & 3;
#pragma unroll
        for (int ai = 0; ai < 2; ++ai)
#pragma unroll
            for (int mp = 0; mp < 4; mp += 2) {
                u32x2 p[2];
#pragma unroll
                for (int q = 0; q < 2; ++q) { const int m = mp + q; const float rs = rsv[ai * 4 + m]; f32x4 o[2];
#pragma unroll
                    for (int n = 0; n < 2; ++n) { const f32x4 gq = acc[ai][0][m][n] * rs, uq = acc[ai][1][m][n] * rs;
#pragma unroll
                        for (int i = 0; i < 4; ++i) o[n][i] = gq[i] * sigmoidf_(gq[i]) * uq[i]; }
                    p[q] = pack8_fp8(o[0], o[1]); }
                const auto lo = __builtin_amdgcn_permlane16_swap(p[0].x, p[1].x, false, false), hi = __builtin_amdgcn_permlane16_swap(p[0].y, p[1].y, false, false);
                const unsigned a = (fq & 1) ? ea[ai * 4 + mp + 1] : ea[ai * 4 + mp];
                if (a != 0xffffffffu) *(u32x4*)(act + (size_t)a * 512 + pnl * 128 + wc * 32 + 16 * (fq >> 1)) = (u32x4){(unsigned)lo[0], (unsigned)hi[0], (unsigned)lo[1], (unsigned)hi[1]}; }
    }
};

struct EpiDown {
    unsigned char* yc; const unsigned* list;
    __device__ __forceinline__ void prefetch(const Unit& u, int wr, int fr, unsigned (&ea)[8], float (&ef)[8]) const {
        EPI_ROWLOOP { const int idx = u.ti * 256 + ai * HALF + wr * 64 + m * 16 + fr; const bool ok = idx < u.cnt;
            const unsigned* rp = list + ((size_t)u.e * LISTCAP + (ok ? idx : 0)) * 4; const unsigned a = rp[0]; ea[ai * 4 + m] = ok ? a : 0xffffffffu; ef[ai * 4 + m] = __builtin_bit_cast(float, rp[1]) * 16.0f; }
    }
    __device__ __forceinline__ void operator()(const f32x4 (&acc)[2][2][4][2], const Unit& u, int wr, int wc, int fr, int fq, const unsigned (&ea)[8], const float (&wv)[8]) const {
        const int pnl = u.pn & 3, col0 = pnl * 256 + wc * 64 + 16 * fq;
        EPI_ROWLOOP { const unsigned a = ea[ai * 4 + m];
            if (a != 0xffffffffu) { const float w = wv[ai * 4 + m];
                const u32x2 p0 = pack8_fp8(acc[ai][0][m][0] * w, acc[ai][0][m][1] * w), p1 = pack8_fp8(acc[ai][1][m][0] * w, acc[ai][1][m][1] * w);
                *(u32x4*)(yc + (size_t)a * 1024 + col0) = (u32x4){p0.x, p0.y, p1.x, p1.y}; } }
    }
};

struct MoeOrder {
    const PG8_LAS int* tpre;
    const PG8_LAS int* cnts;
    const unsigned* list; int G, c, total, shift; unsigned rowbytes;
    __device__ __forceinline__ bool next(int i, Unit& u) const {
        const int L = i * G + c; if (L >= total) return false;
        const int tt = L >> 2; int e = 0;
        for (int j = 1; j < NEXP; ++j) e += (tt >= tpre[j]) ? 1 : 0;
        e = __builtin_amdgcn_readfirstlane(e);
        u.e = e; u.ti = __builtin_amdgcn_readfirstlane(tt - tpre[e]); u.cnt = __builtin_amdgcn_readfirstlane(cnts[e]); u.pn = e * 4 + (L & 3); u.pm = tt; return true;
    }
    __device__ __forceinline__ unsigned arow(const Unit& u, int tr) const { int idx = u.ti * 256 + tr; idx = idx < u.cnt ? idx : u.cnt - 1; const unsigned a = list[((size_t)u.e * LISTCAP + idx) * 4]; return (a >> shift) * rowbytes; }
    __device__ __forceinline__ void a_ready(const Unit&) const {}
    __device__ __forceinline__ void done(const Unit&) const {}
};
#undef EPI_ROWLOOP
}

namespace attn_body {
using bf16=__hip_bfloat16;
using bf16x8=__attribute__((ext_vector_type(8)))short;
using s16x4=__attribute__((ext_vector_type(4)))short;
using f32x16=__attribute__((ext_vector_type(16)))float;
using u32x4=__attribute__((ext_vector_type(4)))unsigned;
using f32x4=__attribute__((ext_vector_type(4)))float;
constexpr int SEQ=2048,D=64,PQ=512;
constexpr int NW=8,QBLK=32,QB=QBLK*NW,KVBLK=64,NQB=SEQ/QB;
constexpr int ATTN_UNIT_ROWS=QB;
__device__ __forceinline__ int crow(int r,int hi){return (r&3)+8*(r>>2)+4*hi;}
#define SBAR() __builtin_amdgcn_sched_barrier(0)
__device__ __forceinline__ void cmask(f32x16&p0,f32x16&p1,int jb,int qrel,int hi){
  const float NEG=-INFINITY; int kb=64*jb+4*hi;
  #pragma unroll
  for(int r=0;r<16;++r){int kv=kb+(r&3)+8*(r>>2); if(kv>qrel)p0[r]=NEG; if(kv+32>qrel)p1[r]=NEG;}
}

constexpr int NSLOT=3, SLOTB=8192;
constexpr int LDS_K=0, LDS_V=NSLOT*SLOTB, LDS_WS=2*NSLOT*SLOTB, LDS_OST=LDS_WS+NW*64*4, LDS_BYTES=LDS_OST+NW*4096;
constexpr float C2=0.125f*1.4426950408889634f;
__device__ __forceinline__ void glds16(const void*gsrc,unsigned lds_dst){unsigned keep;
  asm volatile("s_mov_b32 %0, m0\n\ts_mov_b32 m0, %2\n\ts_nop 0\n\tglobal_load_lds_dwordx4 %1, off\n\ts_mov_b32 m0, %0":"=&s"(keep):"v"(gsrc),"s"(lds_dst):"memory");}
__device__ __forceinline__ float max3f(float a,float b,float c){float r;asm("v_max3_f32 %0, %1, %2, %3":"=v"(r):"v"(a),"v"(b),"v"(c));return r;}
__device__ __forceinline__ float max2f(float a,float b){float r;asm("v_max_f32_e32 %0, %1, %2":"=v"(r):"v"(a),"v"(b));return r;}
__device__ __forceinline__ float fadd_s(float a,float b){float r;asm("v_add_f32_e32 %0, %1, %2":"=v"(r):"v"(a),"v"(b));return r;}
__device__ __forceinline__ float fsub_s(float a,float b){float r;asm("v_sub_f32_e32 %0, %1, %2":"=v"(r):"v"(a),"v"(b));return r;}
typedef float f32x2_t __attribute__((ext_vector_type(2))); typedef __bf16 bf16x2_t __attribute__((ext_vector_type(2)));
__device__ __forceinline__ unsigned cvtpk_s(float lo,float hi){f32x2_t v={lo,hi};bf16x2_t b=__builtin_convertvector(v,bf16x2_t);return __builtin_bit_cast(unsigned,b);}
#define WAIT_BAR(N) asm volatile("s_waitcnt vmcnt(" #N ") lgkmcnt(0)\n\ts_barrier":::"memory")

__device__ __forceinline__ void qkt(f32x16&p0,f32x16&p1,const char*Kslot,const bf16x8*qr,const f32x16&negm,int r32,int hi){
  const char*kb=Kslot+hi*1024+r32*16;
  #pragma unroll
  for(int d0=0;d0<4;++d0){
    const bf16x8 b0=*reinterpret_cast<const bf16x8*>(kb+d0*2048);
    const bf16x8 b1=*reinterpret_cast<const bf16x8*>(kb+d0*2048+512);
    if(d0==0){p0=__builtin_amdgcn_mfma_f32_32x32x16_bf16(b0,qr[0],negm,0,0,0);p1=__builtin_amdgcn_mfma_f32_32x32x16_bf16(b1,qr[0],negm,0,0,0);}
    else{p0=__builtin_amdgcn_mfma_f32_32x32x16_bf16(b0,qr[d0],p0,0,0,0);p1=__builtin_amdgcn_mfma_f32_32x32x16_bf16(b1,qr[d0],p1,0,0,0);}}
}
typedef __attribute__((address_space(3))) const char* lds_cptr;
typedef short v4i16_t __attribute__((ext_vector_type(4)));
__device__ __forceinline__ void kload8(bf16x8*kf,lds_cptr kp){
  kf[0]=*(const __attribute__((address_space(3))) bf16x8*)(kp);      kf[1]=*(const __attribute__((address_space(3))) bf16x8*)(kp+512);
  kf[2]=*(const __attribute__((address_space(3))) bf16x8*)(kp+2048); kf[3]=*(const __attribute__((address_space(3))) bf16x8*)(kp+2560);
  kf[4]=*(const __attribute__((address_space(3))) bf16x8*)(kp+4096); kf[5]=*(const __attribute__((address_space(3))) bf16x8*)(kp+4608);
  kf[6]=*(const __attribute__((address_space(3))) bf16x8*)(kp+6144); kf[7]=*(const __attribute__((address_space(3))) bf16x8*)(kp+6656);
}
__device__ __forceinline__ void kload2(bf16x8*kf,lds_cptr kp,int j){ kf[2*j]=*(const __attribute__((address_space(3))) bf16x8*)(kp+j*2048); kf[2*j+1]=*(const __attribute__((address_space(3))) bf16x8*)(kp+j*2048+512); }
__device__ __forceinline__ s16x4 vtr(lds_cptr p){ return __builtin_bit_cast(s16x4,__builtin_amdgcn_ds_read_tr16_b64_v4i16((__attribute__((address_space(3))) v4i16_t*)p)); }
__device__ __forceinline__ float rowmax(const f32x16&p0,const f32x16&p1){
  float a=max3f(p0[0],p0[1],p1[0]),b=max3f(p0[2],p0[3],p1[1]);a=max3f(a,p1[2],p1[3]);
  #pragma unroll
  for(int r=4;r<16;r+=4){a=max3f(a,p0[r],p0[r+1]);b=max3f(b,p0[r+2],p0[r+3]);a=max3f(a,p1[r],p1[r+1]);b=max3f(b,p1[r+2],p1[r+3]);}
  const float m=max2f(a,b);
  auto rr=__builtin_amdgcn_permlane32_swap(__float_as_uint(m),__float_as_uint(m),false,false);
  return max2f(__uint_as_float(rr[0]),__uint_as_float(rr[1]));
}
__device__ __forceinline__ void pv(f32x16*o,int vb,bf16x8 pa0,bf16x8 pa1,bf16x8 pa2,bf16x8 pa3){
  #pragma unroll
  for(int d0=0;d0<2;++d0){s16x4 lo[4],hi[4];
    #pragma unroll
    for(int ks=0;ks<4;++ks){
      asm volatile("ds_read_b64_tr_b16 %0,%1 offset:%c2":"=&v"(lo[ks]):"v"(vb),"i"(d0*4096+ks*1024):"memory");
      asm volatile("ds_read_b64_tr_b16 %0,%1 offset:%c2":"=&v"(hi[ks]):"v"(vb),"i"(d0*4096+ks*1024+512):"memory");}
    asm volatile("s_waitcnt lgkmcnt(0)":::"memory");SBAR();
    #define PK(k) (bf16x8){lo[k][0],lo[k][1],lo[k][2],lo[k][3],hi[k][0],hi[k][1],hi[k][2],hi[k][3]}
    o[d0]=__builtin_amdgcn_mfma_f32_32x32x16_bf16(pa0,PK(0),o[d0],0,0,0);
    o[d0]=__builtin_amdgcn_mfma_f32_32x32x16_bf16(pa1,PK(1),o[d0],0,0,0);
    o[d0]=__builtin_amdgcn_mfma_f32_32x32x16_bf16(pa2,PK(2),o[d0],0,0,0);
    o[d0]=__builtin_amdgcn_mfma_f32_32x32x16_bf16(pa3,PK(3),o[d0],0,0,0);
    #undef PK
  }
}

#ifndef ATTN_STORE16
#define ATTN_STORE16(p,v) (*(u32x4*)(p)=(v))
#endif
template<int THRL,bool MOBA,int PO,bool NOMASK=false> __device__ __forceinline__ int attn_unit(int qb,const bf16*Qb,const bf16*__restrict__ Kh,const bf16*__restrict__ Vh,bf16*Ob,const float*kmA,const float*kmB,char*shm,int s0,bool pre,const bf16*nKh,const bf16*nVh){
  int tid_=threadIdx.x; asm volatile("":"+v"(tid_));
  const int tid=tid_,lane=tid&63,r32=lane&31,hi=lane>>5; const int wid=__builtin_amdgcn_readfirstlane(tid>>6);
  const int q0=qb*QB;
  const bf16*Qw=Qb+(long)(q0+wid*QBLK)*PQ;
  const unsigned lds0=(unsigned)(uintptr_t)shm;
  float*wsf=(float*)(shm+LDS_WS)+wid*64;
  const bf16*ksrc=Kh+(long)lane*PQ+wid*8;
  const bf16*vsrc=Vh+(long)(16*(wid&3)+(lane>>2))*PQ+(wid>>2)*32+(lane&3)*8;
  const unsigned kdst=lds0+LDS_K+wid*1024, vdst=lds0+LDS_V+wid*1024;
  #define DMA_K(t,slot) glds16(ksrc+(long)(t)*KVBLK*PQ,(unsigned)__builtin_amdgcn_readfirstlane(kdst+(slot)))
  #define DMA_V(t,slot) glds16(vsrc+(long)(t)*KVBLK*PQ,(unsigned)__builtin_amdgcn_readfirstlane(vdst+(slot)))
  const int vb0=(int)(lds0+LDS_V)+((lane>>4)&1)*32+(lane&3)*8+(4*hi+((lane&15)>>2))*64;
  const char*Kbase=shm+LDS_K; bf16x8 kf[8];
  const lds_cptr shm3=(lds_cptr)shm; const lds_cptr kp0=shm3+LDS_K+hi*1024+r32*16; const lds_cptr vp0=shm3+LDS_V+((lane>>4)&1)*32+(lane&3)*8+(4*hi+((lane&15)>>2))*64;
  const int NT=(q0+QB)/KVBLK;
  const int S0=s0,S1=(S0==(NSLOT-1)*SLOTB)?0:S0+SLOTB,S2=(S1==(NSLOT-1)*SLOTB)?0:S1+SLOTB;
  if(!pre){DMA_K(0,S0);DMA_V(0,S0);DMA_K(1,S1);}
  bf16x8 qr[4];
  #pragma unroll
  for(int d0=0;d0<4;++d0)qr[d0]=*reinterpret_cast<const bf16x8*>(&Qw[(long)r32*PQ+d0*16+hi*8]);
  unsigned selmask=0xFFu;
  if constexpr(MOBA){
    f32x16 gt=f32x16{};
    #pragma unroll
    for(int d0=0;d0<4;++d0){ const bf16x8 kfm=*(const __attribute__((address_space(3))) bf16x8*)((lds_cptr)kmA+d0*1024+lane*16);
      gt=__builtin_amdgcn_mfma_f32_32x32x16_bf16(kfm,qr[d0],gt,0,0,0); }
    float gv[8];
    #pragma unroll
    for(int i=0;i<4;++i){ auto rr=__builtin_amdgcn_permlane32_swap(__float_as_uint(gt[i]),__float_as_uint(gt[i]),false,false); gv[i]=__uint_as_float(rr[0]); gv[4+i]=__uint_as_float(rr[1]); }
    unsigned sel=0u;
    #pragma unroll
    for(int k=0;k<3;++k){ float best=-INFINITY; int bi=8;
      #pragma unroll
      for(int j=0;j<8;++j){ const bool ok=(j<qb)&&(((sel>>j)&1u)==0u)&&(gv[j]>best); best=ok?gv[j]:best; bi=ok?j:bi; }
      sel|=(bi<8)?(1u<<bi):0u; }
    selmask=sel|(1u<<qb);
  }
  #define MMASK(P0,P1,t) do{ if constexpr(MOBA&&!NOMASK){ const bool keep_=((selmask>>((t)>>2))&1u)!=0u; _Pragma("unroll") for(int r=0;r<16;++r){P0[r]=keep_?P0[r]:-INFINITY;P1[r]=keep_?P1[r]:-INFINITY;} } }while(0)
  float mhat=0.f,l_reg=0.f;f32x16 o[2];o[0]=f32x16{};o[1]=f32x16{};f32x16 negm=f32x16{};asm volatile("":"+v"(negm)); f32x16 negk=negm;
  const int qrel=wid*QBLK+r32;
  #define CMASK(P0,P1,t) do{int jb_=(t)-(NT-4); if(jb_>=0)cmask(P0,P1,jb_,qrel,hi);}while(0)
  bool resc=false;
  #define START(P0,P1) do{ const float rm=rowmax(P0,P1); resc=false; \
    { const float dl=(rm==-INFINITY)?0.f:rm; mhat=fadd_s(mhat,dl); \
      _Pragma("unroll") for(int r=0;r<16;++r){P0[r]=fsub_s(P0[r],dl);P1[r]=fsub_s(P1[r],dl);} \
      _Pragma("unroll") for(int r=0;r<16;++r)negm[r]=-mhat; asm volatile("":"+v"(negm)); } \
    _Pragma("unroll") for(int r=0;r<16;++r)P0[r]=__builtin_amdgcn_exp2f(P0[r]); }while(0)
  #define RESC() do{ if(resc){ asm volatile("s_waitcnt lgkmcnt(0)":::"memory"); \
      _Pragma("unroll") for(int d_=0;d_<2;++d_) _Pragma("unroll") for(int r=0;r<16;++r)o[d_][r]*=wsf[crow(r,hi)]; } }while(0)
  f32x16 pA0,pA1,pB0,pB1;
  int sl_prev=S0,sl_cur=S0,sl_next=S1;
  #define ROT() do{sl_prev=sl_cur;sl_cur=sl_next;sl_next=(sl_next==(NSLOT-1)*SLOTB)?0:sl_next+SLOTB;}while(0)
  DMA_K(2,S2);
  WAIT_BAR(3);
  qkt(pA0,pA1,Kbase+S0,qr,negm,r32,hi);asm volatile("s_nop 15\n\ts_nop 7":"+v"(pA0),"+v"(pA1));MMASK(pA0,pA1,0);CMASK(pA0,pA1,0);
  START(pA0,pA1);
  { const bool kn_=!MOBA||(((selmask>>0)&1u)!=0u); const float nv_=kn_?-mhat:-INFINITY; _Pragma("unroll") for(int r=0;r<16;++r)negk[r]=nv_; asm volatile("":"+v"(negk)); }
  _Pragma("unroll") for(int r=0;r<16;++r)pA1[r]=__builtin_amdgcn_exp2f(pA1[r]);
  WAIT_BAR(0);
  DMA_K(3,S0);DMA_V(1,S1);
  ROT();
  kload8(kf,kp0+sl_cur);
  WAIT_BAR(2);
  s16x4 vlo[4],vhi[4]; u32x4 pw0,pw1,pw2,pw3;
  #define PKW(P,B) cvtpk_s(P[B],P[B+1])
  #define PAF(k) __builtin_bit_cast(bf16x8,pw##k)
  #define VFR(i) (bf16x8){vlo[i][0],vlo[i][1],vlo[i][2],vlo[i][3],vhi[i][0],vhi[i][1],vhi[i][2],vhi[i][3]}
  #define PIN(x) asm volatile("":"+v"(x))
  #define MX3(a,b,c) __builtin_fmaxf(__builtin_fmaxf((a),(b)),(c))
  #define GAPA(MF,A0,A1,A2,A3,W0,W1,PW) do{ MF; sacc+=A0; sacc+=A1; sacc+=A2; sacc+=A3; PIN(sacc); W0; W1; PIN(PW); SBAR(); }while(0)
  #define EX(v) __builtin_amdgcn_exp2f(v)
  #define GAPB(MF,X,B) do{ MF; X[B]=EX(X[B]); X[B+1]=EX(X[B+1]); X[B+2]=EX(X[B+2]); X[B+3]=EX(X[B+3]); PIN(X); SBAR(); }while(0)
  #define VRD(i) do{ vlo[i]=vtr(vp_+(((i)>>2)*4096+((i)&3)*1024)); vhi[i]=vtr(vp_+(((i)>>2)*4096+((i)&3)*1024+512)); }while(0)
  #define VRDX(sl,f) do{ vlo[sl]=vtr(vp_+(((f)>>2)*4096+((f)&3)*1024)); vhi[sl]=vtr(vp_+(((f)>>2)*4096+((f)&3)*1024+512)); SBAR(); }while(0)
  #define KRD(G,j) do{ if(G){ kload2(kf,kp0+sl_next,j); SBAR(); } }while(0)
  #define STEP(C0,C1,P0,P1,t,GK,GV,GL) do{ SBAR(); \
    const lds_cptr vp_=vp0+sl_prev; \
    VRD(0); SBAR(); float sacc=(P0[0]+P0[1]); \
    GAPA(C0=__builtin_amdgcn_mfma_f32_32x32x16_bf16(kf[0],qr[0],negk,0,0,0), P0[2],P0[3],P0[4],P0[5],     pw0[0]=PKW(P0,0), pw0[1]=PKW(P0,2), pw0); \
    GAPA(C1=__builtin_amdgcn_mfma_f32_32x32x16_bf16(kf[1],qr[0],negk,0,0,0), P0[6],P0[7],P0[8],P0[9],     pw0[2]=PKW(P0,4), pw0[3]=PKW(P0,6), pw0); \
    VRD(1); SBAR(); GAPA(C0=__builtin_amdgcn_mfma_f32_32x32x16_bf16(kf[2],qr[1],C0,0,0,0),   P0[10],P0[11],P0[12],P0[13], pw1[0]=PKW(P0,8), pw1[1]=PKW(P0,10), pw1); \
    GAPA(C1=__builtin_amdgcn_mfma_f32_32x32x16_bf16(kf[3],qr[1],C1,0,0,0),   P0[14],P0[15],P1[0],P1[1],   pw1[2]=PKW(P0,12),pw1[3]=PKW(P0,14), pw1); \
    VRD(2); SBAR(); GAPA(C0=__builtin_amdgcn_mfma_f32_32x32x16_bf16(kf[4],qr[2],C0,0,0,0),   P1[2],P1[3],P1[4],P1[5],     pw2[0]=PKW(P1,0), pw2[1]=PKW(P1,2), pw2); \
    GAPA(C1=__builtin_amdgcn_mfma_f32_32x32x16_bf16(kf[5],qr[2],C1,0,0,0),   P1[6],P1[7],P1[8],P1[9],     pw2[2]=PKW(P1,4), pw2[3]=PKW(P1,6), pw2); \
    VRD(3); SBAR(); GAPA(C0=__builtin_amdgcn_mfma_f32_32x32x16_bf16(kf[6],qr[3],C0,0,0,0),   P1[10],P1[11],P1[12],P1[13], pw3[0]=PKW(P1,8), pw3[1]=PKW(P1,10), pw3); \
    GAPA(C1=__builtin_amdgcn_mfma_f32_32x32x16_bf16(kf[7],qr[3],C1,0,0,0),   P1[14],P1[15],0.f,0.f,       pw3[2]=PKW(P1,12),pw3[3]=PKW(P1,14), pw3); \
    l_reg+=sacc; \
    if(GK){DMA_K((t)+3,sl_cur);} if(GV){DMA_V((t)+1,sl_next);} \
    CMASK(C0,C1,t); \
    { float a=MX3(C0[0],C0[1],C1[0]),b=MX3(C0[2],C0[3],C1[1]); a=MX3(a,C1[2],C1[3]); \
      _Pragma("unroll") for(int r=4;r<16;r+=4){a=MX3(a,C0[r],C0[r+1]);b=MX3(b,C0[r+2],C0[r+3]);a=MX3(a,C1[r],C1[r+1]);b=MX3(b,C1[r+2],C1[r+3]);} \
      float rm=__builtin_fmaxf(a,b); { auto rr=__builtin_amdgcn_permlane32_swap(__float_as_uint(rm),__float_as_uint(rm),false,false); rm=__builtin_fmaxf(__uint_as_float(rr[0]),__uint_as_float(rr[1])); } \
      resc=false; \
      if(__builtin_expect(__any(rm>(float)THRL),0)){ const float dl=__builtin_fmaxf(rm,0.f); mhat+=dl; \
        _Pragma("unroll") for(int r=0;r<16;++r){C0[r]-=dl;C1[r]-=dl;} \
        _Pragma("unroll") for(int r=0;r<16;++r)negm[r]=-mhat; asm volatile("":"+v"(negm)); \
        const float f=__builtin_amdgcn_exp2f(-dl); l_reg*=f; if(hi==0)wsf[r32]=f; resc=true; } } \
    SBAR(); \
    GAPB(o[0]=__builtin_amdgcn_mfma_f32_32x32x16_bf16(PAF(0),VFR(0),o[0],0,0,0), C0,0); VRDX(0,4); \
    GAPB(o[0]=__builtin_amdgcn_mfma_f32_32x32x16_bf16(PAF(1),VFR(1),o[0],0,0,0), C0,4); VRDX(1,5); \
    KRD(GL,0); GAPB(o[0]=__builtin_amdgcn_mfma_f32_32x32x16_bf16(PAF(2),VFR(2),o[0],0,0,0), C0,8); VRDX(2,6); \
    KRD(GL,1); GAPB(o[0]=__builtin_amdgcn_mfma_f32_32x32x16_bf16(PAF(3),VFR(3),o[0],0,0,0), C0,12); VRDX(3,7); \
    KRD(GL,2); GAPB(o[1]=__builtin_amdgcn_mfma_f32_32x32x16_bf16(PAF(0),VFR(0),o[1],0,0,0), C1,0); \
    KRD(GL,3); GAPB(o[1]=__builtin_amdgcn_mfma_f32_32x32x16_bf16(PAF(1),VFR(1),o[1],0,0,0), C1,4); \
    GAPB(o[1]=__builtin_amdgcn_mfma_f32_32x32x16_bf16(PAF(2),VFR(2),o[1],0,0,0), C1,8); \
    GAPB(o[1]=__builtin_amdgcn_mfma_f32_32x32x16_bf16(PAF(3),VFR(3),o[1],0,0,0), C1,12); \
    { if((MOBA&&(((t)+1)&3)==0)||resc){ const bool kn_=!MOBA||((selmask>>(((t)+1)>>2))&1u)!=0u; const float nv_=kn_?-mhat:-INFINITY; _Pragma("unroll") for(int r=0;r<16;++r)negk[r]=nv_; asm volatile("":"+v"(negk)); } } \
    }while(0)
  int t=1;
  #undef CMASK
  #define CMASK(P0,P1,t) do{}while(0)
  for(;t+5<NT;t+=2){
    STEP(pB0,pB1,pA0,pA1,t,true,true,true);     WAIT_BAR(2); RESC(); ROT();
    STEP(pA0,pA1,pB0,pB1,t+1,true,true,true);   WAIT_BAR(2); RESC(); ROT();
  }
  #undef CMASK
  #define CMASK(P0,P1,t) do{int jb_=(t)-(NT-4); if(jb_>=0)cmask(P0,P1,jb_,qrel,hi);}while(0)
  #define ENDW(tt) do{ if((tt)+3<NT){WAIT_BAR(2);} else if((tt)+2<NT){WAIT_BAR(1);} else {WAIT_BAR(0);} }while(0)
  for(;t+1<NT;t+=2){
    STEP(pB0,pB1,pA0,pA1,t,(t+3<NT),(t+1<NT),(t+1<NT));       ENDW(t);   RESC(); ROT();
    STEP(pA0,pA1,pB0,pB1,t+1,(t+4<NT),(t+2<NT),(t+2<NT));     ENDW(t+1); RESC(); ROT();
  }
  STEP(pB0,pB1,pA0,pA1,NT-1,false,false,false); RESC();
  const int N0=(sl_cur==(NSLOT-1)*SLOTB)?0:sl_cur+SLOTB;
  if(nKh){ const int N1=(N0==(NSLOT-1)*SLOTB)?0:N0+SLOTB; const bf16*nks=nKh+(long)lane*PQ+wid*8; const bf16*nvs=nVh+(long)(16*(wid&3)+(lane>>2))*PQ+(wid>>2)*32+(lane&3)*8;
    glds16(nks,(unsigned)__builtin_amdgcn_readfirstlane(kdst+N0)); glds16(nvs,(unsigned)__builtin_amdgcn_readfirstlane(vdst+N0)); glds16(nks+(long)KVBLK*PQ,(unsigned)__builtin_amdgcn_readfirstlane(kdst+N1)); }
  if(wid>=6)
  { float sacc=pB0[0]+pB0[1]; _Pragma("unroll") for(int r=2;r<16;++r)sacc+=pB0[r]; _Pragma("unroll") for(int r=0;r<16;++r)sacc+=pB1[r]; l_reg+=sacc;
    pw0=(u32x4){PKW(pB0,0),PKW(pB0,2),PKW(pB0,4),PKW(pB0,6)};pw1=(u32x4){PKW(pB0,8),PKW(pB0,10),PKW(pB0,12),PKW(pB0,14)};pw2=(u32x4){PKW(pB1,0),PKW(pB1,2),PKW(pB1,4),PKW(pB1,6)};pw3=(u32x4){PKW(pB1,8),PKW(pB1,10),PKW(pB1,12),PKW(pB1,14)};
    SBAR(); pv(o,vb0+sl_cur,PAF(0),PAF(1),PAF(2),PAF(3)); }
  #undef PKW
  #undef PAF
  #undef VFR
  #undef PIN
  #undef MX3
  #undef GAPA
  #undef GAPB
  #undef EX
  #undef VRD
  #undef VRDX
  #undef KRD
  #undef STEP
  #undef ENDW
  {auto rr=__builtin_amdgcn_permlane32_swap(__float_as_uint(l_reg),__float_as_uint(l_reg),false,false);l_reg=__uint_as_float(rr[0])+__uint_as_float(rr[1]);}
  if(hi==0)wsf[32+r32]=l_reg;asm volatile("s_waitcnt lgkmcnt(0)":::"memory");
  float rli[16];
  #pragma unroll
  for(int r=0;r<16;++r)rli[r]=__builtin_amdgcn_rcpf(wsf[32+crow(r,hi)]);
  bf16*Ow=Ob+(long)(q0+wid*QBLK)*PO;
  { bf16*stg=(bf16*)(shm+LDS_OST)+wid*2048;
    #pragma unroll
    for(int r=0;r<16;++r){const int orow=crow(r,hi);
      #pragma unroll
      for(int d0=0;d0<2;++d0)stg[orow*64+d0*32+r32]=__float2bfloat16(o[d0][r]*rli[r]);}
    asm volatile("s_waitcnt lgkmcnt(0)":::"memory");
    #pragma unroll
    for(int i=0;i<4;++i){const int row=i*8+(lane>>3),ch=lane&7; const u32x4 v=*(const u32x4*)(stg+row*64+ch*8); ATTN_STORE16(Ow+(long)row*PO+ch*8,v);} }
  asm volatile("s_waitcnt lgkmcnt(0)\n\ts_barrier":::"memory");
  #undef DMA_K
  #undef DMA_V
  #undef CMASK
  #undef MMASK
  #undef START
  #undef RESC
  #undef ROT
  return N0;
}
template<int THRL,int PO> __device__ __forceinline__ int attn_unit128(int qb,const bf16*Qb,const bf16*__restrict__ Kh,const bf16*__restrict__ Vh,bf16*Ob,char*shm,int s0,bool pre,const bf16*nKh,const bf16*nVh){
  constexpr bool MOBA=false; constexpr int LDS_V=NSLOT*SLOTB, LDS_WS=LDS_V+NSLOT*2*SLOTB, LDS_OST=LDS_WS+NW*64*4;
  const float*kmA=nullptr,*kmB=nullptr;
  int tid_=threadIdx.x; asm volatile("":"+v"(tid_));
  const int tid=tid_,lane=tid&63,r32=lane&31,hi=lane>>5; const int wid=__builtin_amdgcn_readfirstlane(tid>>6);
  const int q0=qb*QB;
  const bf16*Qw=Qb+(long)(q0+wid*QBLK)*PQ;
  const unsigned lds0=(unsigned)(uintptr_t)shm;
  float*wsf=(float*)(shm+LDS_WS)+wid*64;
  const bf16*ksrc=Kh+(long)lane*PQ+wid*8;
  const bf16*vsrc=Vh+(long)(16*(wid&3)+(lane>>2))*PQ+(wid>>2)*32+(lane&3)*8;
  const unsigned kdst=lds0+LDS_K+wid*1024, vdst=lds0+LDS_V+wid*1024;
  #define DMA_K(t,slot) glds16(ksrc+(long)(t)*KVBLK*PQ,(unsigned)__builtin_amdgcn_readfirstlane(kdst+(slot)))
  #define DMA_V(t,slot) do{ glds16(vsrc+(long)(t)*KVBLK*PQ,(unsigned)__builtin_amdgcn_readfirstlane(vdst+2*(slot))); glds16(vsrc+64+(long)(t)*KVBLK*PQ,(unsigned)__builtin_amdgcn_readfirstlane(vdst+2*(slot)+8192)); }while(0)
  const int vb0=(int)(lds0+LDS_V)+((lane>>4)&1)*32+(lane&3)*8+(4*hi+((lane&15)>>2))*64;
  const char*Kbase=shm+LDS_K; bf16x8 kf[8];
  const lds_cptr shm3=(lds_cptr)shm; const lds_cptr kp0=shm3+LDS_K+hi*1024+r32*16; const lds_cptr vp0=shm3+LDS_V+((lane>>4)&1)*32+(lane&3)*8+(4*hi+((lane&15)>>2))*64;
  const int NT=(q0+QB)/KVBLK;
  const int S0=s0,S1=(S0==(NSLOT-1)*SLOTB)?0:S0+SLOTB,S2=(S1==(NSLOT-1)*SLOTB)?0:S1+SLOTB;
  if(!pre){DMA_K(0,S0);DMA_V(0,S0);DMA_K(1,S1);}
  bf16x8 qr[4];
  #pragma unroll
  for(int d0=0;d0<4;++d0)qr[d0]=*reinterpret_cast<const bf16x8*>(&Qw[(long)r32*PQ+d0*16+hi*8]);
  unsigned selmask=0xFFu;
  if constexpr(MOBA){
    f32x16 gt=f32x16{}; const int jr=r32&7; const float kz=(r32<8)?(1.f/256.f):0.f;
    #pragma unroll
    for(int d0=0;d0<4;++d0){ const float*p0=kmA+jr*64+d0*16+hi*8; const float*p1=kmB+jr*64+d0*16+hi*8;
      const f32x4 a0=*(const f32x4*)p0,a1=*(const f32x4*)(p0+4),b0=*(const f32x4*)p1,b1=*(const f32x4*)(p1+4);
      u32x4 w; w[0]=cvtpk_s((a0[0]+b0[0])*kz,(a0[1]+b0[1])*kz); w[1]=cvtpk_s((a0[2]+b0[2])*kz,(a0[3]+b0[3])*kz); w[2]=cvtpk_s((a1[0]+b1[0])*kz,(a1[1]+b1[1])*kz); w[3]=cvtpk_s((a1[2]+b1[2])*kz,(a1[3]+b1[3])*kz);
      gt=__builtin_amdgcn_mfma_f32_32x32x16_bf16(__builtin_bit_cast(bf16x8,w),qr[d0],gt,0,0,0); }
    float gv[8];
    #pragma unroll
    for(int i=0;i<4;++i){ auto rr=__builtin_amdgcn_permlane32_swap(__float_as_uint(gt[i]),__float_as_uint(gt[i]),false,false); gv[i]=__uint_as_float(rr[0]); gv[4+i]=__uint_as_float(rr[1]); }
    unsigned sel=0u;
    #pragma unroll
    for(int k=0;k<3;++k){ float best=-INFINITY; int bi=8;
      #pragma unroll
      for(int j=0;j<8;++j){ const bool ok=(j<qb)&&(((sel>>j)&1u)==0u)&&(gv[j]>best); best=ok?gv[j]:best; bi=ok?j:bi; }
      sel|=(bi<8)?(1u<<bi):0u; }
    selmask=sel|(1u<<qb);
  }
  #define MMASK(P0,P1,t) do{ if constexpr(MOBA){ const bool keep_=((selmask>>((t)>>2))&1u)!=0u; _Pragma("unroll") for(int r=0;r<16;++r){P0[r]=keep_?P0[r]:-INFINITY;P1[r]=keep_?P1[r]:-INFINITY;} } }while(0)
  float zz=0.f; asm volatile("":"+v"(zz));
  float mhat=0.f,l_reg=0.f;f32x16 o[4],negm; _Pragma("unroll") for(int r=0;r<16;++r){o[0][r]=zz;o[1][r]=zz;o[2][r]=zz;o[3][r]=zz;negm[r]=zz;} asm volatile("":"+v"(negm));
  const int qrel=wid*QBLK+r32;
  #define CMASK(P0,P1,t) do{int jb_=(t)-(NT-4); if(jb_>=0)cmask(P0,P1,jb_,qrel,hi);}while(0)
  bool resc=false;
  #define START(P0,P1) do{ const float rm=rowmax(P0,P1); resc=false; \
    { const float dl=(rm==-INFINITY)?0.f:rm; mhat=fadd_s(mhat,dl); \
      _Pragma("unroll") for(int r=0;r<16;++r){P0[r]=fsub_s(P0[r],dl);P1[r]=fsub_s(P1[r],dl);} \
      _Pragma("unroll") for(int r=0;r<16;++r)negm[r]=-mhat; asm volatile("":"+v"(negm)); } \
    _Pragma("unroll") for(int r=0;r<16;++r)P0[r]=__builtin_amdgcn_exp2f(P0[r]); }while(0)
  #define RESC() do{ if(resc){ asm volatile("s_waitcnt lgkmcnt(0)":::"memory"); \
      _Pragma("unroll") for(int d_=0;d_<4;++d_) _Pragma("unroll") for(int r=0;r<16;++r)o[d_][r]*=wsf[crow(r,hi)]; } }while(0)
  f32x16 pA0,pA1,pB0,pB1;
  int sl_prev=S0,sl_cur=S0,sl_next=S1;
  #define ROT() do{sl_prev=sl_cur;sl_cur=sl_next;sl_next=(sl_next==(NSLOT-1)*SLOTB)?0:sl_next+SLOTB;}while(0)
  DMA_K(2,S2);
  WAIT_BAR(4);
  qkt(pA0,pA1,Kbase+S0,qr,negm,r32,hi);asm volatile("s_nop 15\n\ts_nop 7":"+v"(pA0),"+v"(pA1));MMASK(pA0,pA1,0);CMASK(pA0,pA1,0);
  START(pA0,pA1);
  _Pragma("unroll") for(int r=0;r<16;++r)pA1[r]=__builtin_amdgcn_exp2f(pA1[r]);
  WAIT_BAR(0);
  DMA_K(3,S0);DMA_V(1,S1);
  ROT();
  kload8(kf,kp0+sl_cur);
  WAIT_BAR(3);
  s16x4 vlo[4],vhi[4]; u32x4 pw0,pw1,pw2,pw3;
  #define PKW(P,B) cvtpk_s(P[B],P[B+1])
  #define PAF(k) __builtin_bit_cast(bf16x8,pw##k)
  #define VFR(i) (bf16x8){vlo[i][0],vlo[i][1],vlo[i][2],vlo[i][3],vhi[i][0],vhi[i][1],vhi[i][2],vhi[i][3]}
  #define PIN(x) asm volatile("":"+v"(x))
  #define MX3(a,b,c) __builtin_fmaxf(__builtin_fmaxf((a),(b)),(c))
  #define GAPA(MF,A0,A1,A2,A3,W0,W1,PW) do{ MF; sacc+=A0; sacc+=A1; sacc+=A2; sacc+=A3; PIN(sacc); W0; W1; PIN(PW); SBAR(); }while(0)
  #define EX(v) __builtin_amdgcn_exp2f(v)
  #define GAPB(MF,X,B) do{ MF; if(((B)>>1)&1){rmB_=MX3(rmB_,X[B],X[B+1]);}else{rmA_=MX3(rmA_,X[B],X[B+1]);} X[B]=EX(X[B]); X[B+1]=EX(X[B+1]); PIN(X); PIN(rmA_); PIN(rmB_); SBAR(); }while(0)
  #define VRDX(sl,f) do{ vlo[sl]=vtr(vp_+(((f)>>2)*4096+((f)&3)*1024)); vhi[sl]=vtr(vp_+(((f)>>2)*4096+((f)&3)*1024+512)); SBAR(); }while(0)
  #define VRD(i) do{ vlo[i]=vtr(vp_+(((i)>>2)*4096+((i)&3)*1024)); vhi[i]=vtr(vp_+(((i)>>2)*4096+((i)&3)*1024+512)); }while(0)
  #define KRD(G,j) do{ if(G){ kload2(kf,kp0+sl_next,j); SBAR(); } }while(0)
  #define STEP(C0,C1,P0,P1,t,GK,GV,GL) do{ SBAR(); \
    const lds_cptr vp_=vp0+2*sl_prev; \
    VRD(0); SBAR(); float sacc=(P0[0]+P0[1]); \
    GAPA(C0=__builtin_amdgcn_mfma_f32_32x32x16_bf16(kf[0],qr[0],negm,0,0,0), P0[2],P0[3],P0[4],P0[5],     pw0[0]=PKW(P0,0), pw0[1]=PKW(P0,2), pw0); \
    GAPA(C1=__builtin_amdgcn_mfma_f32_32x32x16_bf16(kf[1],qr[0],negm,0,0,0), P0[6],P0[7],P0[8],P0[9],     pw0[2]=PKW(P0,4), pw0[3]=PKW(P0,6), pw0); \
    VRD(1); SBAR(); GAPA(C0=__builtin_amdgcn_mfma_f32_32x32x16_bf16(kf[2],qr[1],C0,0,0,0),   P0[10],P0[11],P0[12],P0[13], pw1[0]=PKW(P0,8), pw1[1]=PKW(P0,10), pw1); \
    GAPA(C1=__builtin_amdgcn_mfma_f32_32x32x16_bf16(kf[3],qr[1],C1,0,0,0),   P0[14],P0[15],P1[0],P1[1],   pw1[2]=PKW(P0,12),pw1[3]=PKW(P0,14), pw1); \
    VRD(2); SBAR(); GAPA(C0=__builtin_amdgcn_mfma_f32_32x32x16_bf16(kf[4],qr[2],C0,0,0,0),   P1[2],P1[3],P1[4],P1[5],     pw2[0]=PKW(P1,0), pw2[1]=PKW(P1,2), pw2); \
    GAPA(C1=__builtin_amdgcn_mfma_f32_32x32x16_bf16(kf[5],qr[2],C1,0,0,0),   P1[6],P1[7],P1[8],P1[9],     pw2[2]=PKW(P1,4), pw2[3]=PKW(P1,6), pw2); \
    VRD(3); SBAR(); GAPA(C0=__builtin_amdgcn_mfma_f32_32x32x16_bf16(kf[6],qr[3],C0,0,0,0),   P1[10],P1[11],P1[12],P1[13], pw3[0]=PKW(P1,8), pw3[1]=PKW(P1,10), pw3); \
    GAPA(C1=__builtin_amdgcn_mfma_f32_32x32x16_bf16(kf[7],qr[3],C1,0,0,0),   P1[14],P1[15],0.f,0.f,       pw3[2]=PKW(P1,12),pw3[3]=PKW(P1,14), pw3); \
    l_reg+=sacc; \
    if(GK){DMA_K((t)+3,sl_cur);} if(GV){DMA_V((t)+1,sl_next);} \
    MMASK(C0,C1,t); CMASK(C0,C1,t); \
    float rmA_=-INFINITY,rmB_=-INFINITY; SBAR(); \
    GAPB(o[0]=__builtin_amdgcn_mfma_f32_32x32x16_bf16(PAF(0),VFR(0),o[0],0,0,0), C0,0); VRDX(0,4); \
    GAPB(o[0]=__builtin_amdgcn_mfma_f32_32x32x16_bf16(PAF(1),VFR(1),o[0],0,0,0), C0,2); VRDX(1,5); \
    KRD(GL,0); GAPB(o[0]=__builtin_amdgcn_mfma_f32_32x32x16_bf16(PAF(2),VFR(2),o[0],0,0,0), C0,4); VRDX(2,6); \
    KRD(GL,1); GAPB(o[0]=__builtin_amdgcn_mfma_f32_32x32x16_bf16(PAF(3),VFR(3),o[0],0,0,0), C0,6); VRDX(3,7); \
    KRD(GL,2); GAPB(o[1]=__builtin_amdgcn_mfma_f32_32x32x16_bf16(PAF(0),VFR(0),o[1],0,0,0), C0,8); VRDX(0,8); \
    KRD(GL,3); GAPB(o[1]=__builtin_amdgcn_mfma_f32_32x32x16_bf16(PAF(1),VFR(1),o[1],0,0,0), C0,10); VRDX(1,9); \
    GAPB(o[1]=__builtin_amdgcn_mfma_f32_32x32x16_bf16(PAF(2),VFR(2),o[1],0,0,0), C0,12); VRDX(2,10); \
    GAPB(o[1]=__builtin_amdgcn_mfma_f32_32x32x16_bf16(PAF(3),VFR(3),o[1],0,0,0), C0,14); VRDX(3,11); \
    GAPB(o[2]=__builtin_amdgcn_mfma_f32_32x32x16_bf16(PAF(0),VFR(0),o[2],0,0,0), C1,0); VRDX(0,12); \
    GAPB(o[2]=__builtin_amdgcn_mfma_f32_32x32x16_bf16(PAF(1),VFR(1),o[2],0,0,0), C1,2); VRDX(1,13); \
    GAPB(o[2]=__builtin_amdgcn_mfma_f32_32x32x16_bf16(PAF(2),VFR(2),o[2],0,0,0), C1,4); VRDX(2,14); \
    GAPB(o[2]=__builtin_amdgcn_mfma_f32_32x32x16_bf16(PAF(3),VFR(3),o[2],0,0,0), C1,6); VRDX(3,15); \
    GAPB(o[3]=__builtin_amdgcn_mfma_f32_32x32x16_bf16(PAF(0),VFR(0),o[3],0,0,0), C1,8); \
    GAPB(o[3]=__builtin_amdgcn_mfma_f32_32x32x16_bf16(PAF(1),VFR(1),o[3],0,0,0), C1,10); \
    GAPB(o[3]=__builtin_amdgcn_mfma_f32_32x32x16_bf16(PAF(2),VFR(2),o[3],0,0,0), C1,12); \
    GAPB(o[3]=__builtin_amdgcn_mfma_f32_32x32x16_bf16(PAF(3),VFR(3),o[3],0,0,0), C1,14); \
    { float rm=__builtin_fmaxf(rmA_,rmB_); { auto rr=__builtin_amdgcn_permlane32_swap(__float_as_uint(rm),__float_as_uint(rm),false,false); rm=__builtin_fmaxf(__uint_as_float(rr[0]),__uint_as_float(rr[1])); } \
      resc=false; \
      if(__builtin_expect(__any(rm>(float)THRL),0)){ const float dl=__builtin_fmaxf(rm,0.f); mhat+=dl; const float f=__builtin_amdgcn_exp2f(-dl); \
        _Pragma("unroll") for(int r=0;r<16;++r){C0[r]*=f;C1[r]*=f;} \
        _Pragma("unroll") for(int r=0;r<16;++r)negm[r]=-mhat; asm volatile("":"+v"(negm)); \
        l_reg*=f; if(hi==0)wsf[r32]=f; resc=true; } } \
    }while(0)
  int t=1;
  #undef CMASK
  #define CMASK(P0,P1,t) do{}while(0)
  for(;t+5<NT;t+=2){
    STEP(pB0,pB1,pA0,pA1,t,true,true,true);     WAIT_BAR(3); RESC(); ROT();
    STEP(pA0,pA1,pB0,pB1,t+1,true,true,true);   WAIT_BAR(3); RESC(); ROT();
  }
  #undef CMASK
  #define CMASK(P0,P1,t) do{int jb_=(t)-(NT-4); if(jb_>=0)cmask(P0,P1,jb_,qrel,hi);}while(0)
  #define ENDW(tt) do{ if((tt)+3<NT){WAIT_BAR(3);} else if((tt)+2<NT){WAIT_BAR(2);} else {WAIT_BAR(0);} }while(0)
  for(;t+1<NT;t+=2){
    STEP(pB0,pB1,pA0,pA1,t,(t+3<NT),(t+1<NT),(t+1<NT));       ENDW(t);   RESC(); ROT();
    STEP(pA0,pA1,pB0,pB1,t+1,(t+4<NT),(t+2<NT),(t+2<NT));     ENDW(t+1); RESC(); ROT();
  }
  STEP(pB0,pB1,pA0,pA1,NT-1,false,false,false); RESC();
  const int N0=(sl_cur==(NSLOT-1)*SLOTB)?0:sl_cur+SLOTB;
  if(nKh){ const int N1=(N0==(NSLOT-1)*SLOTB)?0:N0+SLOTB; const bf16*nks=nKh+(long)lane*PQ+wid*8; const bf16*nvs=nVh+(long)(16*(wid&3)+(lane>>2))*PQ+(wid>>2)*32+(lane&3)*8;
    glds16(nks,(unsigned)__builtin_amdgcn_readfirstlane(kdst+N0)); glds16(nvs,(unsigned)__builtin_amdgcn_readfirstlane(vdst+2*N0)); glds16(nvs+64,(unsigned)__builtin_amdgcn_readfirstlane(vdst+2*N0+8192)); glds16(nks+(long)KVBLK*PQ,(unsigned)__builtin_amdgcn_readfirstlane(kdst+N1)); }
  if(wid>=6)
  { float sacc=pB0[0]+pB0[1]; _Pragma("unroll") for(int r=2;r<16;++r)sacc+=pB0[r]; _Pragma("unroll") for(int r=0;r<16;++r)sacc+=pB1[r]; l_reg+=sacc;
    pw0=(u32x4){PKW(pB0,0),PKW(pB0,2),PKW(pB0,4),PKW(pB0,6)};pw1=(u32x4){PKW(pB0,8),PKW(pB0,10),PKW(pB0,12),PKW(pB0,14)};pw2=(u32x4){PKW(pB1,0),PKW(pB1,2),PKW(pB1,4),PKW(pB1,6)};pw3=(u32x4){PKW(pB1,8),PKW(pB1,10),PKW(pB1,12),PKW(pB1,14)};
    SBAR(); pv(o,vb0+2*sl_cur,PAF(0),PAF(1),PAF(2),PAF(3)); pv(o+2,vb0+2*sl_cur+8192,PAF(0),PAF(1),PAF(2),PAF(3)); }
  #undef PKW
  #undef PAF
  #undef VFR
  #undef PIN
  #undef MX3
  #undef GAPA
  #undef GAPB
  #undef EX
  #undef VRD
  #undef VRDX
  #undef KRD
  #undef STEP
  #undef ENDW
  {auto rr=__builtin_amdgcn_permlane32_swap(__float_as_uint(l_reg),__float_as_uint(l_reg),false,false);l_reg=__uint_as_float(rr[0])+__uint_as_float(rr[1]);}
  if(hi==0)wsf[32+r32]=l_reg;asm volatile("s_waitcnt lgkmcnt(0)":::"memory");
  float rli[16];
  #pragma unroll
  for(int r=0;r<16;++r)rli[r]=__builtin_amdgcn_rcpf(wsf[32+crow(r,hi)]);
  bf16*Ow=Ob+(long)(q0+wid*QBLK)*PO;
  { bf16*stg=(bf16*)(shm+LDS_OST)+wid*2048;
    #pragma unroll
    for(int c=0;c<2;++c){
      #pragma unroll
      for(int r=0;r<16;++r){const int orow=crow(r,hi);
        #pragma unroll
        for(int d0=0;d0<2;++d0)stg[orow*64+d0*32+r32]=__float2bfloat16(o[2*c+d0][r]*rli[r]);}
      asm volatile("s_waitcnt lgkmcnt(0)":::"memory");
      #pragma unroll
      for(int i=0;i<4;++i){const int row=i*8+(lane>>3),ch=lane&7; const u32x4 v=*(const u32x4*)(stg+row*64+ch*8); ATTN_STORE16(Ow+(long)row*PO+c*64+ch*8,v);}
      asm volatile("s_waitcnt lgkmcnt(0)":::"memory"); } }
  asm volatile("s_waitcnt lgkmcnt(0)\n\ts_barrier":::"memory");
  #undef DMA_K
  #undef DMA_V
  #undef CMASK
  #undef MMASK
  #undef START
  #undef RESC
  #undef ROT
  return N0;
}
constexpr int ATTN_LDS_BYTES=LDS_BYTES;
#undef SBAR
#undef WAIT_BAR
}


#ifndef DUP2_MOBA
#define DUP2_MOBA 0
#endif
#ifndef DUPD_HALF
#define DUPD_HALF -1
#endif
constexpr int NWAVES = 8;
constexpr int N_LAUNCHES = MK_N_LAUNCHES;
constexpr int N_PHASES = 10;
static_assert(N_LAUNCHES == 1 || N_LAUNCHES == N_PHASES, "MK_N_LAUNCHES is 1 or 10");

constexpr size_t MiB = 1u << 20;
constexpr size_t WS_CTL = 0, CTL_ZERO_BYTES = 1 * MiB;
constexpr size_t WS_ROPE = 1 * MiB;
constexpr size_t WS_KPART = 2 * MiB;
constexpr size_t WS_SSQP = 3 * MiB;
constexpr size_t WS_LIST = 56 * MiB;
constexpr size_t WS_WIN = 10 * MiB, WS_WBM = 20 * MiB, WS_WBD = 21 * MiB, WS_WOUT = 22 * MiB, WS_W13 = 24 * MiB, WS_W2 = 88 * MiB;
#ifndef WS_H8_MIB
#define WS_H8_MIB 376
#endif
constexpr size_t WS_H8 = (size_t)(WS_H8_MIB) * MiB;
constexpr size_t WS_WIN8 = 104 * MiB;
#ifndef WS_H_MIB
#define WS_H_MIB 448
#endif
constexpr size_t WS_H = (size_t)(WS_H_MIB) * MiB;
#ifndef WS_R6_MIB
#define WS_R6_MIB 184
#endif
constexpr size_t WS_R6 = (size_t)(WS_R6_MIB) * MiB;
constexpr size_t WS_QA = WS_R6, WS_KA = WS_R6 + 32 * MiB, WS_VA = WS_R6 + 64 * MiB, WS_QD = WS_R6 + 96 * MiB;
constexpr size_t WS_OA = WS_QA;
constexpr size_t WS_ODF = WS_H8;
constexpr size_t WS_MERGED = WS_QD;
constexpr size_t WS_X1F8 = WS_QA;
constexpr size_t WS_ACT = WS_KA;
constexpr size_t WS_YC = WS_VA;
#ifndef WS_GATES_MIB
#define WS_GATES_MIB 120
#endif
constexpr size_t WS_GATES = (size_t)(WS_GATES_MIB) * MiB;
constexpr size_t WS_X1 = WS_GATES;
constexpr size_t WS_END = 512 * MiB;
constexpr bool ws_disjoint(size_t a, size_t an, size_t b, size_t bn) { return a + an <= b || b + bn <= a; }
constexpr size_t SZ_H = (size_t)T * 2048, SZ_H8 = (size_t)T * 1024, SZ_GATES = (size_t)T * 2048, SZ_R6 = 6 * 32 * MiB, SZ_LOW = 120 * MiB;
static_assert(WS_W2 + (size_t)NEXP * 1024 * 512 <= WS_WIN8 && WS_WIN8 + (size_t)INC * 1024 <= SZ_LOW && WS_H + SZ_H <= WS_END && WS_H8 + SZ_H8 <= WS_END && WS_GATES + SZ_GATES <= WS_END && WS_R6 + SZ_R6 <= WS_END, "d_ws map");
static_assert(ws_disjoint(WS_H, SZ_H, WS_R6, SZ_R6) && ws_disjoint(WS_H, SZ_H, WS_GATES, SZ_GATES) && ws_disjoint(WS_H, SZ_H, WS_H8, SZ_H8) && ws_disjoint(WS_H8, SZ_H8, WS_R6, SZ_R6) && ws_disjoint(WS_H8, SZ_H8, WS_GATES, SZ_GATES) && ws_disjoint(WS_GATES, SZ_GATES, WS_R6, SZ_R6), "d_ws map");
static_assert((WS_H >= SZ_LOW) && (WS_GATES >= SZ_LOW) && (WS_H8 >= SZ_LOW || (WS_H8 == 56 * MiB)) && WS_W13 + 32 * MiB <= 56 * MiB && 88 * MiB == WS_W2, "d_ws map");
static_assert(WS_YC + (size_t)2 * T * 1024 <= WS_R6 + SZ_R6 && WS_ACT + (size_t)2 * T * 512 <= WS_YC && WS_X1F8 + (size_t)T * 1024 <= WS_ACT && WS_LIST + (size_t)NEXP * LISTCAP * 16 <= WS_W2 && WS_LIST >= WS_W13 + 32 * MiB && (WS_H8 >= SZ_LOW), "d_ws overlays");
constexpr int CW_TMO = 0, CW_CODE = 1;
constexpr int CW_BAR = 4096;
constexpr int CW_CNT = 8192;

constexpr int RING_OFF = 0, RING_BYTES = 131072;
constexpr int LDSCTL_OFF = RING_BYTES, MISC_OFF = LDSCTL_OFF + 320;
constexpr int LDS_BYTES = 147456;
static_assert(MISC_OFF + 128 <= LDS_BYTES, "LDS map");

#define GAS __attribute__((address_space(1)))
#define LAS __attribute__((address_space(3)))
typedef unsigned short bf16;
typedef unsigned v4u __attribute__((ext_vector_type(4)));
typedef float f32x4 __attribute__((ext_vector_type(4)));
typedef short bf16x8 __attribute__((ext_vector_type(8)));
typedef GAS unsigned gu32;
typedef GAS unsigned long long gu64;
#define RLX_AGENT __ATOMIC_RELAXED, __HIP_MEMORY_SCOPE_AGENT
#define LDS_WAIT() asm volatile("s_waitcnt lgkmcnt(0)" ::: "memory")
#define VM_WAIT() asm volatile("s_waitcnt vmcnt(0)" ::: "memory")
__device__ __forceinline__ unsigned long long rt() { return __builtin_amdgcn_s_memrealtime(); }
__device__ __forceinline__ unsigned f2bf(float f) { unsigned u = __builtin_bit_cast(unsigned, f); return (u + 0x7fffu + ((u >> 16) & 1u)) >> 16; }
__device__ __forceinline__ unsigned pk2(float lo, float hi) { return f2bf(lo) | (f2bf(hi) << 16); }

#define XB_TMO      128
#define XB_XCNT(j)  (256  + 64 * (j))
#define XB_XSUB(j)  (1280 + 64 * (j))
#define XB_XGEN(j)  (2304 + 64 * (j))
#define XB_TOP      3328
#define XB_TOPGEN   3392
#define XCD_BAR_WORDS 3456
#define XB_SPIN_CAP (1u << 18)

__device__ __forceinline__ unsigned xb_ld(unsigned* p)              { return __hip_atomic_load(p, __ATOMIC_RELAXED, __HIP_MEMORY_SCOPE_AGENT); }
__device__ __forceinline__ unsigned xb_add(unsigned* p, unsigned v) { return __hip_atomic_fetch_add(p, v, __ATOMIC_RELAXED, __HIP_MEMORY_SCOPE_AGENT); }
__device__ __forceinline__ unsigned xb_xcc_id() { return (unsigned)__builtin_amdgcn_s_getreg((3 << 11) | 20) & 0xFu; }
#define XB_SPIN(cond, bar) do { unsigned _sp = 0; while (cond) { __builtin_amdgcn_s_sleep(1); \
    if ((++_sp & 255u) == 0u) { if (xb_ld(&(bar)[XB_TMO])) break; if (_sp > XB_SPIN_CAP) { atomicAdd(&(bar)[XB_TMO], 1u); break; } } } } while (0)

struct XcdBarrier {
    unsigned* bar; unsigned x;
    volatile LAS unsigned* st;
};

__device__ __forceinline__ XcdBarrier xcd_barrier_post(unsigned* bar, volatile LAS unsigned* st) {
    XcdBarrier b; b.bar = bar; b.x = xb_xcc_id(); b.st = st;
    if (threadIdx.x == 0) (void)xb_add(&bar[XB_XCNT(b.x)], 1u);
    return b;
}
__device__ __forceinline__ void xcd_barrier_complete(unsigned* bar, unsigned x, unsigned& nloc, unsigned& nx) {
    const unsigned G = gridDim.x * gridDim.y * gridDim.z;
    unsigned sum, cnt, mine, sp = 0u;
    for (;;) {
        sum = 0u; cnt = 0u; mine = 0u;
#pragma unroll
        for (unsigned j = 0; j < 16; ++j) { const unsigned c = xb_ld(&bar[XB_XCNT(j)]); sum += c; cnt += (c > 0u) ? 1u : 0u; mine = (j == x) ? c : mine; }
        if (sum == G) break;
        __builtin_amdgcn_s_sleep(1);
        if ((++sp & 255u) == 0u) { if (xb_ld(&bar[XB_TMO])) break; if (sp > XB_SPIN_CAP) { atomicAdd(&bar[XB_TMO], 1u); break; } }
    }
    nloc = mine > 0u ? mine : 1u; nx = cnt > 0u ? cnt : 1u;
}

__device__ __forceinline__ void xcd_barrier(const XcdBarrier& b) {
    asm volatile("s_waitcnt vmcnt(0)" ::: "memory");
    __syncthreads();
    if (threadIdx.x == 0) {
        unsigned* bar = b.bar;
        __builtin_amdgcn_s_waitcnt(0);
        unsigned nloc = b.st[0], nx = b.st[1];
        if (nloc == 0u) { xcd_barrier_complete(bar, b.x, nloc, nx); b.st[0] = nloc; b.st[1] = nx; }
        const unsigned old = xb_add(&bar[XB_XSUB(b.x)], 1u);
        const unsigned gen = old / nloc;
        if (old + 1u == (gen + 1u) * nloc) {
            __builtin_amdgcn_fence(__ATOMIC_RELEASE, "agent");
            asm volatile("s_waitcnt vmcnt(0)" ::: "memory");
            const unsigned og = xb_add(&bar[XB_TOP], 1u);
            const unsigned tg = og / nx;
            if (og + 1u == (tg + 1u) * nx) xb_add(&bar[XB_TOPGEN], 1u);
            else XB_SPIN(xb_ld(&bar[XB_TOPGEN]) == tg, bar);
            __builtin_amdgcn_fence(__ATOMIC_ACQUIRE, "agent");
            xb_add(&bar[XB_XGEN(b.x)], 1u);
            asm volatile("s_waitcnt vmcnt(0)" ::: "memory");
        } else {
            XB_SPIN(xb_ld(&bar[XB_XGEN(b.x)]) == gen, bar);
            __builtin_amdgcn_fence(__ATOMIC_ACQUIRE, "agent");
            asm volatile("s_waitcnt vmcnt(0)" ::: "memory");
        }
    }
    __syncthreads();
}

struct Args { const float* in[20]; float* out; unsigned char* ws; int ph_lo, ph_hi; };

template <class F> __device__ __forceinline__ void xcd_barrier_work(const XcdBarrier& b, F&& f) {
    asm volatile("s_waitcnt vmcnt(0)" ::: "memory");
    __syncthreads();
    if (threadIdx.x == 0) {
        unsigned* bar = b.bar;
        __builtin_amdgcn_s_waitcnt(0);
        unsigned nloc = b.st[0], nx = b.st[1];
        if (nloc == 0u) { xcd_barrier_complete(bar, b.x, nloc, nx); b.st[0] = nloc; b.st[1] = nx; }
        const unsigned old = xb_add(&bar[XB_XSUB(b.x)], 1u);
        const unsigned gen = old / nloc;
        if (old + 1u == (gen + 1u) * nloc) {
            __builtin_amdgcn_fence(__ATOMIC_RELEASE, "agent");
            asm volatile("s_waitcnt vmcnt(0)" ::: "memory");
            const unsigned og = xb_add(&bar[XB_TOP], 1u);
            const unsigned tg = og / nx;
            if (og + 1u == (tg + 1u) * nx) xb_add(&bar[XB_TOPGEN], 1u);
            else XB_SPIN(xb_ld(&bar[XB_TOPGEN]) == tg, bar);
            __builtin_amdgcn_fence(__ATOMIC_ACQUIRE, "agent");
            xb_add(&bar[XB_XGEN(b.x)], 1u);
            asm volatile("s_waitcnt vmcnt(0)" ::: "memory");
        } else {
            XB_SPIN(xb_ld(&bar[XB_XGEN(b.x)]) == gen, bar);
            __builtin_amdgcn_fence(__ATOMIC_ACQUIRE, "agent");
            asm volatile("s_waitcnt vmcnt(0)" ::: "memory");
        }
    } else if (threadIdx.x >= 64) f((int)threadIdx.x - 64, NWAVES * 64 - 64);
    __syncthreads();
}

typedef float f32x16 __attribute__((ext_vector_type(16)));
typedef unsigned u32x2 __attribute__((ext_vector_type(2)));
typedef float f32x2v __attribute__((ext_vector_type(2)));

__device__ __forceinline__ float wave_sum(float v) {
#pragma unroll
    for (int o = 1; o < 64; o <<= 1) v += __shfl_xor(v, o);
    return v;
}
__device__ __forceinline__ float bf2f_lo(unsigned w) { return __builtin_bit_cast(float, w << 16); }
__device__ __forceinline__ float bf2f_hi(unsigned w) { return __builtin_bit_cast(float, w & 0xffff0000u); }

__device__ __forceinline__ int rowmap(int code, int n0) {
    if (code == 1) { const int pn = n0 >> 8; const bool rope = (pn < 4) || (pn >= 6 && pn < 10); if (!rope) return n0; const int hh = (n0 & 255) >> 6, half = (n0 & 63) >> 5; return (pn << 8) + 64 * hh + 8 * half; }
    if (code == 2) return 256 * (n0 >> 7) + 64 * ((n0 & 127) >> 5);
    if (code == 3) return 256 * (n0 >> 7) + 64 * ((n0 & 127) >> 5) + 8;
    return n0;
}
__device__ __forceinline__ int rowstep(int code, int n0) {
    if (code == 1) { const int pn = n0 >> 8; const bool rope = (pn < 4) || (pn >= 6 && pn < 10); return rope ? 16 : 8; }
    return (code == 2 || code == 3) ? 16 : 8;
}
struct P0Item { const float* W; unsigned char* dst; const float* kscale; float scale; int N, K, k0, n0, r0, f8, rs; };
__device__ __forceinline__ P0Item p0_decode(const Args& A, int it) {
    constexpr int I_IN = 16 * 160, I_BM = 8 * 32, I_OUT = 16 * 32, I_E = 256;
    unsigned char* ws = A.ws; P0Item d; d.kscale = nullptr; d.scale = 1.f; d.f8 = 0; int code = 0, item = it, r = it;
    if (r < I_IN) { const int pn = (r % 160) >> 3; d.W = A.in[2]; d.K = 1024; d.N = INC; code = 1; if (pn < 6 || pn >= 6 + pg8::P1_NB) { d.f8 = 1; d.scale = pn >= 12 ? -64.f * 1.4426950408889634f : 64.f; d.dst = ws + WS_WIN8; }     else d.dst = ws + WS_WIN; }
    else if ((r -= I_IN) < I_BM) { d.W = A.in[3]; d.K = 512; d.N = 1024; d.dst = ws + WS_WBM; item = r; }
    else if ((r -= I_BM) < I_BM) { d.W = A.in[4]; d.K = 512; d.N = 1024; d.dst = ws + WS_WBD; item = r; }
    else if ((r -= I_BM) < I_OUT) { d.W = A.in[5]; d.K = 1024; d.N = 1024; d.dst = ws + WS_WOUT; item = r; }
    else if ((r -= I_OUT) < NEXP * I_E) { const int e = r >> 8; d.W = A.in[16] + (size_t)e * 1024 * 512; d.K = 1024; d.N = 512; d.dst = ws + WS_W13 + (size_t)e * 1024 * 1024; code = 2; d.f8 = 1; d.scale = 64.f; d.kscale = A.in[11]; item = r & 255; }
    else if ((r -= NEXP * I_E) < NEXP * I_E) { const int e = r >> 8; d.W = A.in[17] + (size_t)e * 1024 * 512; d.K = 1024; d.N = 512; d.dst = ws + WS_W13 + (size_t)e * 1024 * 1024; code = 3; d.f8 = 1; d.scale = 64.f; d.kscale = A.in[11]; item = r & 255; }
    else { r -= NEXP * I_E; const int e = r >> 8; d.W = A.in[18] + (size_t)e * 512 * 1024; d.K = 512; d.N = 1024; d.dst = ws + WS_W2 + (size_t)e * 1024 * 512; d.f8 = 1; d.scale = 32.f; item = r & 255; }
    const int nblk = d.N / 32, kb = item / nblk, nb = item % nblk; d.k0 = 64 * kb; d.n0 = 32 * nb; d.r0 = rowmap(code, d.n0); d.rs = rowstep(code, d.n0);
    return d;
}
__device__ __forceinline__ void p0_load(const P0Item& d, float (&wv)[32], int lane) {
#pragma unroll
    for (int i = 0; i < 32; ++i) { const int kk = 2 * i + (lane >> 5); wv[i] = __builtin_nontemporal_load(d.W + (size_t)(d.k0 + kk) * d.N + d.n0 + (lane & 31)); }
}
__device__ __forceinline__ void p0_finish(const P0Item& d, const float (&wv)[32], LAS float* scr, int lane) {
#pragma unroll
    for (int i = 0; i < 32; ++i) { const int kk = 2 * i + (lane >> 5); scr[kk * 33 + (lane & 31)] = wv[i]; }
    LDS_WAIT(); asm volatile("" ::: "memory");
    if (d.f8) {
        const int c = lane & 3;
        float gs[16];
#pragma unroll
        for (int q = 0; q < 16; ++q) gs[q] = d.kscale ? d.kscale[d.k0 + 16 * c + q] * d.scale : d.scale;
#pragma unroll
        for (int j = 0; j < 2; ++j) { const int n = (lane >> 2) + 16 * j; const LAS float* s = scr + (16 * c) * 33 + n;
            v4u o;
#pragma unroll
            for (int q = 0; q < 4; ++q) { int w = 0; w = __builtin_amdgcn_cvt_pk_fp8_f32(s[(4 * q) * 33] * gs[4 * q], s[(4 * q + 1) * 33] * gs[4 * q + 1], w, false);
                w = __builtin_amdgcn_cvt_pk_fp8_f32(s[(4 * q + 2) * 33] * gs[4 * q + 2], s[(4 * q + 3) * 33] * gs[4 * q + 3], w, true); o[q] = (unsigned)w; }
            *(GAS v4u*)(d.dst + (size_t)(d.r0 + (n & 7) + d.rs * (n >> 3)) * d.K + d.k0 + 16 * c) = o; }
    } else {
        const int c = lane & 7;
#pragma unroll
        for (int j = 0; j < 4; ++j) { const int n = (lane >> 3) + 8 * j; const LAS float* s = scr + (8 * c) * 33 + n;
            v4u o; o.x = pk2(s[0 * 33], s[1 * 33]); o.y = pk2(s[2 * 33], s[3 * 33]); o.z = pk2(s[4 * 33], s[5 * 33]); o.w = pk2(s[6 * 33], s[7 * 33]);
            *(GAS v4u*)((bf16*)d.dst + (size_t)(d.r0 + (n & 7) + d.rs * (n >> 3)) * d.K + d.k0 + 8 * c) = o; }
    }
    LDS_WAIT(); asm volatile("" ::: "memory");
}
constexpr int P0_NITEMS = 16 * 160 + 2 * 8 * 32 + 16 * 32 + 3 * NEXP * 256, P0_FIXED = 16 * 160 + 2 * 8 * 32 + 16 * 32;
constexpr int P0_W2_FIRST = P0_FIXED + 2 * NEXP * 256, P0_W2_N = NEXP * 256;
__device__ __forceinline__ void p0_run(const Args& A, LAS float* scr, int lane, int j0, int step, int jend, int base) {
    if (j0 >= jend) return;
    float wA[32], wB[32]; P0Item dA = p0_decode(A, base + j0), dB = dA; int jA = j0;
    p0_load(dA, wA, lane);
    for (;;) {
        const int jB = jA + step; const bool hasB = jB < jend;
        if (hasB) { dB = p0_decode(A, base + jB); p0_load(dB, wB, lane); }
        p0_finish(dA, wA, scr, lane);
        if (!hasB) break;
        jA = jB + step; const bool hasA = jA < jend;
        if (hasA) { dA = p0_decode(A, base + jA); p0_load(dA, wA, lane); }
        p0_finish(dB, wB, scr, lane);
        if (!hasA) break;
    }
}
#ifndef SH_IPW2
#define SH_IPW2 4
#endif
constexpr int P0_POOL0 = 16 * 160, P0_POOLN = 2 * 8 * 32 + 16 * 32 + 2 * NEXP * 256;
__device__ __forceinline__ int sh_ipw(int s) { return s == 2 ? SH_IPW2 : 2; }
__device__ __forceinline__ int sh_off(int s, int G) { int o = 0; for (int i = 0; i < s; ++i) o += sh_ipw(i); return o * 7 * G; }
__device__ __forceinline__ int sh_cover(int G) { const int c = sh_off(4, G); return c < P0_POOLN ? c : P0_POOLN; }
__device__ __forceinline__ void p0_shadow(LAS unsigned char* lds, const Args& A, int vcu, int G, int s, int t) {
    const int lane = t & 63, w = __builtin_amdgcn_readfirstlane(t >> 6);
    LAS float* scr = (LAS float*)(lds + RING_OFF + (w + 1) * 16384);
    const int off = sh_off(s, G), left = sh_cover(G) - off, n = sh_ipw(s) * 7 * G;
    p0_run(A, scr, lane, vcu * 7 + w, 7 * G, n < left ? n : left, P0_POOL0 + off);
}
__device__ __forceinline__ void p0_tail_w2(LAS unsigned char* lds, const Args& A, int vcu, int G, int total, int tid) {
    const int lane = tid & 63, w = __builtin_amdgcn_readfirstlane(tid >> 6);
    LAS float* scr = (LAS float*)(lds + RING_OFF + w * 16384);
    const int maxU = (total + G - 1) / G, nlong = total - (maxU - 1) * G, nshort = nlong >= G ? 0 : G - nlong;
    int Tn = nshort * NWAVES * 8; Tn = Tn < P0_W2_N ? Tn : P0_W2_N;
    if (vcu >= nlong) p0_run(A, scr, lane, (vcu - nlong) * NWAVES + w, nshort * NWAVES, Tn, P0_W2_FIRST);
    p0_run(A, scr, lane, Tn + vcu * NWAVES + w, G * NWAVES, P0_W2_N, P0_W2_FIRST);
}
__device__ __forceinline__ void p0_prologue(LAS unsigned char* lds, const Args& A, int vcu, int G, int tid, int nsh) {
    const int lane = tid & 63, wave = __builtin_amdgcn_readfirstlane(tid >> 6);
    unsigned char* ws = A.ws;
    LAS float* scr = (LAS float*)(lds + RING_OFF + wave * 16384);
    const int gw = vcu * NWAVES + wave, NGW = G * NWAVES;
    const int skip = nsh > 0 ? sh_cover(G) : 0, NITEMS = (nsh > 0 ? P0_W2_FIRST : P0_NITEMS) - skip;
#define P0_MAP(j) ((j) < P0_POOL0 ? (j) : (j) + skip)
    if (gw < NITEMS) {
        float wA[32], wB[32]; P0Item dA = p0_decode(A, P0_MAP(gw)), dB = dA; int itA = gw;
        p0_load(dA, wA, lane);
        for (;;) {
            const int itB = itA + NGW; const bool hasB = itB < NITEMS;
            if (hasB) { dB = p0_decode(A, P0_MAP(itB)); p0_load(dB, wB, lane); }
            p0_finish(dA, wA, scr, lane);
            if (!hasB) break;
            itA = itB + NGW; const bool hasA = itA < NITEMS;
            if (hasA) { dA = p0_decode(A, P0_MAP(itA)); p0_load(dA, wA, lane); }
            p0_finish(dB, wB, scr, lane);
            if (!hasA) break;
        }
    }
#undef P0_MAP
    { const float* gm = A.in[1]; f32x4 gv[4];
#pragma unroll
        for (int j = 0; j < 4; ++j) gv[j] = ((const GAS f32x4*)gm)[lane + 64 * j];
        bf16* H = (bf16*)(ws + WS_H); unsigned char* H8 = (unsigned char*)(ws + WS_H8);
        for (int m = gw; m < T; m += 2 * NGW) {
            const int m2 = m + NGW;
            const GAS f32x4* xr = (const GAS f32x4*)(A.in[0] + (size_t)m * DM) + lane; const GAS f32x4* xr2 = (const GAS f32x4*)(A.in[0] + (size_t)(m2 < T ? m2 : m) * DM) + lane;
            f32x4 v[4], u[4]; float s = 0.f, s2 = 0.f;
#pragma unroll
            for (int j = 0; j < 4; ++j) { v[j] = __builtin_nontemporal_load(xr + 64 * j); u[j] = __builtin_nontemporal_load(xr2 + 64 * j); }
#pragma unroll
            for (int j = 0; j < 4; ++j) { s += (v[j].x * v[j].x + v[j].y * v[j].y) + (v[j].z * v[j].z + v[j].w * v[j].w); s2 += (u[j].x * u[j].x + u[j].y * u[j].y) + (u[j].z * u[j].z + u[j].w * u[j].w); }
            const float rstd = 1.0f / sqrtf(wave_sum(s) * (1.f / DM) + EPS), rstd2 = 1.0f / sqrtf(wave_sum(s2) * (1.f / DM) + EPS);
            GAS unsigned long long* o8 = (GAS unsigned long long*)(H + (size_t)m * DM) + lane;
#pragma unroll
            for (int j = 0; j < 4; ++j) { const f32x4 o = v[j] * rstd * gv[j]; if constexpr (pg8::P1_NB > 0) o8[64 * j] = (unsigned long long)pk2(o.x, o.y) | ((unsigned long long)pk2(o.z, o.w) << 32);
                int w = 0; w = __builtin_amdgcn_cvt_pk_fp8_f32(o.x, o.y, w, false); w = __builtin_amdgcn_cvt_pk_fp8_f32(o.z, o.w, w, true); ((GAS unsigned*)(H8 + (size_t)m * DM))[lane + 64 * j] = (unsigned)w; }
            if (m2 < T) { GAS unsigned long long* p8 = (GAS unsigned long long*)(H + (size_t)m2 * DM) + lane;
#pragma unroll
                for (int j = 0; j < 4; ++j) { const f32x4 o = u[j] * rstd2 * gv[j]; if constexpr (pg8::P1_NB > 0) p8[64 * j] = (unsigned long long)pk2(o.x, o.y) | ((unsigned long long)pk2(o.z, o.w) << 32);
                    int w = 0; w = __builtin_amdgcn_cvt_pk_fp8_f32(o.x, o.y, w, false); w = __builtin_amdgcn_cvt_pk_fp8_f32(o.z, o.w, w, true); ((GAS unsigned*)(H8 + (size_t)m2 * DM))[lane + 64 * j] = (unsigned)w; } }
        }
    }
    if (vcu == 0 && tid < 256) ((float*)(ws + WS_ROPE))[2 * SEQ * 32 + tid] = A.in[6 + (tid >> 6)][tid & 63];
    { float* cosT = (float*)(ws + WS_ROPE); float* sinT = cosT + SEQ * 32;
        for (int idx = vcu * (NWAVES * 64) + tid; idx < SEQ * 32; idx += G * NWAVES * 64) { const int s = idx >> 5, d = idx & 31;
            const float inv = 1.0f / powf(10000.0f, (float)(2 * d) / 64.0f); const float ang = (float)s * inv; cosT[idx] = cosf(ang); sinT[idx] = sinf(ang); } }
}

template <bool DO_MOBA, bool DO_DIFF> __device__ __forceinline__ void p2_attention(char* lds, unsigned char* ws, int vcu, int G, void* oa_override, const float* lp  , const float* subg) {
    using attn_body::bf16;
    const bf16* QA = (const bf16*)(ws + WS_QA); const bf16* QD = (const bf16*)(ws + WS_QD);
    const float* kpart = (const float*)(ws + WS_KPART);
    constexpr size_t R = (size_t)T * 512;
    if constexpr (DO_MOBA) { constexpr int NP = BATCH * 8 * 4; const int per = (NP + G - 1) / G; const int pend = (vcu + 1) * per < NP ? (vcu + 1) * per : NP;
        int bh_built = -1; int s0m = 0; bool prem = false;
        for (int p = vcu * per; p < pend; ++p) { const int bh = p >> 2, s = p & 3, b = bh >> 3, h = bh & 7; const size_t ro = (size_t)b * SEQ * 512 + h * 64;
            if (bh != bh_built) {
                const int tid = threadIdx.x, lane = tid & 63, r32 = lane & 31, hi = lane >> 5;
                __syncthreads();
                if (tid < 64) { const float* k0 = kpart + (((size_t)b) * 8 + h) * 512; const float* k1 = kpart + (((size_t)16 + b) * 8 + h) * 512; const int jr = r32 & 7; const float kz = (r32 < 8) ? (1.f / 256.f) : 0.f;
#pragma unroll
                    for (int d0 = 0; d0 < 4; ++d0) { const float* p0 = k0 + jr * 64 + d0 * 16 + hi * 8; const float* p1 = k1 + jr * 64 + d0 * 16 + hi * 8;
                        const f32x4 a0 = *(const GAS f32x4*)p0, a1 = *(const GAS f32x4*)(p0 + 4), b0 = *(const GAS f32x4*)p1, b1 = *(const GAS f32x4*)(p1 + 4);
                        v4u w; w.x = pk2((a0.x + b0.x) * kz, (a0.y + b0.y) * kz); w.y = pk2((a0.z + b0.z) * kz, (a0.w + b0.w) * kz); w.z = pk2((a1.x + b1.x) * kz, (a1.y + b1.y) * kz); w.w = pk2((a1.z + b1.z) * kz, (a1.w + b1.w) * kz);
                        *(LAS v4u*)((LAS unsigned char*)(unsigned)(uintptr_t)lds + 90112 + d0 * 1024 + lane * 16) = w; } }
                __syncthreads(); bh_built = bh; }
            for (int half = 0; half < 2; ++half) { const int qb = half ? 7 - s : s;
                const bf16* nK = nullptr; const bf16* nV = nullptr;
                if (half == 0) { nK = QA + R + ro; nV = QA + 2 * R + ro; }
                else if (p + 1 < pend) { const int bh2 = (p + 1) >> 2; const size_t ro2 = (size_t)(bh2 >> 3) * SEQ * 512 + (bh2 & 7) * 64; if (bh2 == bh) { nK = QA + R + ro2; nV = QA + 2 * R + ro2; } }
                s0m = attn_body::attn_unit<8, true, 512, (DUP2_MOBA == 2) && !DO_DIFF>(qb, QA + ro, QA + R + ro, QA + 2 * R + ro, (oa_override ? (bf16*)oa_override : (bf16*)(ws + WS_OA)) + ro, (const float*)(lds + 90112), nullptr, lds, s0m, prem, nK, nV);
                prem = (nK != nullptr); } } }
    if constexpr (DO_DIFF) { constexpr int NP = BATCH * 4 * 4; const int per = (NP + G - 1) / G; const int pend = (vcu + 1) * per < NP ? (vcu + 1) * per : NP;
        for (int p = vcu * per; p < pend; ++p) { const int b = p >> 4, hd = (p >> 2) & 3, s = p & 3; const size_t rb = (size_t)b * SEQ;
            int s0d = 0; bool pred = false;
            for (int m = 0; m < 2; ++m) {
                for (int half = 0; half < 2; ++half) { const int qb = half ? 7 - s : s;
                    if (!DO_MOBA && DUPD_HALF >= 0 && half != DUPD_HALF) continue;
                    const bf16* Kc = QD + R + rb * 512 + (hd * 2 + m) * 64; const bf16* Vc = QD + 2 * R + rb * 512 + hd * 128;
                    const bf16* nK = nullptr; const bf16* nV = nullptr;
                    if (half == 0) { nK = Kc; nV = Vc; } else if (m == 0) { nK = QD + R + rb * 512 + (hd * 2 + 1) * 64; nV = Vc; }
                    s0d = attn_body::attn_unit128<8, 1024>(qb, QD + rb * 512 + (hd * 2 + m) * 64, Kc, Vc, (bf16*)(ws + WS_H) + rb * 1024 + (hd * 4 + m * 2) * 64, lds, s0d, pred, nK, nV);
                    pred = (nK != nullptr); } }
            asm volatile("s_waitcnt vmcnt(0)" ::: "memory"); __syncthreads();
            if (threadIdx.x == 0) { __builtin_amdgcn_fence(__ATOMIC_ACQUIRE, "agent"); asm volatile("s_waitcnt vmcnt(0)" ::: "memory"); }
            __syncthreads();
            { int tid = threadIdx.x; asm volatile("" : "+v"(tid));
                const int lane = tid & 63, wave = __builtin_amdgcn_readfirstlane(tid >> 6);
                const float lam = __expf(wave_sum(lp[lane] * lp[64 + lane])) - __expf(wave_sum(lp[128 + lane] * lp[192 + lane])) + 0.2f;
                const int e0 = (lane & 15) * 8, cc = e0 >> 6, d0 = e0 & 63; float g[8];
#pragma unroll
                for (int j = 0; j < 8; ++j) g[j] = subg[e0 + j] * 0.8f;
                const unsigned short* OD = (const unsigned short*)(ws + WS_H); unsigned short* OF = (unsigned short*)(ws + WS_ODF);
                for (int it0 = wave; it0 < 128; it0 += 4 * NWAVES) {
                    v4u av[4], bv[4]; size_t rowv[4];
#pragma unroll
                    for (int q = 0; q < 4; ++q) { const int it = it0 + q * NWAVES, rr = it * 4 + (lane >> 4), qb = (rr >> 8) ? 7 - s : s; rowv[q] = rb + (size_t)qb * 256 + (rr & 255);
                        av[q] = *(const GAS v4u*)(OD + rowv[q] * 1024 + (hd * 4 + cc) * 64 + d0); bv[q] = *(const GAS v4u*)(OD + rowv[q] * 1024 + (hd * 4 + 2 + cc) * 64 + d0); }
#pragma unroll
                    for (int q = 0; q < 4; ++q) { const v4u a = av[q], bq = bv[q]; const size_t row = rowv[q];
                        float v[8];
#pragma unroll
                        for (int j = 0; j < 4; ++j) { v[2 * j] = bf2f_lo(a[j]) - lam * bf2f_lo(bq[j]); v[2 * j + 1] = bf2f_hi(a[j]) - lam * bf2f_hi(bq[j]); }
                        float ss = 0.f;
#pragma unroll
                        for (int j = 0; j < 8; ++j) ss += v[j] * v[j];
                        ss += __shfl_xor(ss, 1); ss += __shfl_xor(ss, 2); ss += __shfl_xor(ss, 4); ss += __shfl_xor(ss, 8);
                        const float rstd = 1.0f / sqrtf(ss * (1.f / 128.f) + EPS);
                        v4u o;
#pragma unroll
                        for (int j = 0; j < 4; ++j) o[j] = pk2(v[2 * j] * rstd * g[2 * j], v[2 * j + 1] * rstd * g[2 * j + 1]);
                        *(GAS v4u*)(OF + row * 512 + hd * 128 + e0) = o; } } }
        } }
}

__device__ __forceinline__ void p3_combine(const Args& A, int vcu, int G, int tid) {
    const int lane = tid & 63, wave = __builtin_amdgcn_readfirstlane(tid >> 6);
    const int gw = vcu * NWAVES + wave, NGW = G * NWAVES;
    const float lam = __expf(wave_sum(A.in[6][lane] * A.in[7][lane])) - __expf(wave_sum(A.in[8][lane] * A.in[9][lane])) + 0.2f;
    const int hd = lane >> 4, e0 = (lane & 15) * 8, c = e0 >> 6, d0 = e0 & 63;
    float g[8];
#pragma unroll
    for (int j = 0; j < 8; ++j) g[j] = A.in[10][e0 + j] * 0.8f;
    const bf16* OD = (const bf16*)(A.ws + WS_H); bf16* OF = (bf16*)(A.ws + WS_ODF);
    for (int row = gw; row < T; row += NGW) {
        const v4u a = *(const GAS v4u*)(OD + (size_t)row * 1024 + (hd * 4 + c) * 64 + d0), b = *(const GAS v4u*)(OD + (size_t)row * 1024 + (hd * 4 + 2 + c) * 64 + d0);
        float v[8];
#pragma unroll
        for (int j = 0; j < 4; ++j) { v[2 * j] = bf2f_lo(a[j]) - lam * bf2f_lo(b[j]); v[2 * j + 1] = bf2f_hi(a[j]) - lam * bf2f_hi(b[j]); }
        float ss = 0.f;
#pragma unroll
        for (int j = 0; j < 8; ++j) ss += v[j] * v[j];
        ss += __shfl_xor(ss, 1); ss += __shfl_xor(ss, 2); ss += __shfl_xor(ss, 4); ss += __shfl_xor(ss, 8);
        const float rstd = 1.0f / sqrtf(ss * (1.f / 128.f) + EPS);
        v4u o;
#pragma unroll
        for (int j = 0; j < 4; ++j) o[j] = pk2(v[2 * j] * rstd * g[2 * j], v[2 * j + 1] * rstd * g[2 * j + 1]);
        *(GAS v4u*)(OF + (size_t)row * 512 + hd * 128 + e0) = o;
    }
}

__device__ __forceinline__ void p6_prep(LAS unsigned char* lds, const Args& A, int t, int n) {
    constexpr int WLS = 1032; LAS bf16* Wl = (LAS bf16*)lds;
    const float* wgroup = A.in[12]; const float* wrouter = A.in[14]; const float* gf = A.in[11];
    for (int idx = t; idx < 32 * 1024; idx += n) { const int e = idx & 31, k = idx >> 5; Wl[(4 + e) * WLS + k] = (bf16)f2bf(wrouter[idx] * gf[k]); }
    for (int idx = t; idx < 4 * 1024; idx += n) { const int nn = idx & 3, k = idx >> 2; Wl[nn * WLS + k] = (bf16)f2bf(wgroup[idx] * gf[k]); }
}
__device__ __forceinline__ void p6_router(LAS unsigned char* lds, const Args& A, int vcu, int G, int tid, bool prepped) {
    const int lane = tid & 63, wave = __builtin_amdgcn_readfirstlane(tid >> 6), r32 = lane & 31, hi = lane >> 5;
    constexpr int WLS = 1032;
    LAS bf16* Wl = (LAS bf16*)lds;
    LAS int* lcnt = (LAS int*)(lds + 36 * WLS * 2); LAS int* lbase = lcnt + 32; LAS float* xch = (LAS float*)(lds + 36 * WLS * 2 + 256);
    const float* bgroup = A.in[13]; const float* brouter = A.in[15];
    if (!prepped) p6_prep(lds, A, tid, NWAVES * 64);
    __syncthreads();
    const bf16* x1g = (const bf16*)(A.ws + WS_H); const float* ssqp = (const float*)(A.ws + WS_SSQP);
    unsigned* cnt = (unsigned*)(A.ws + WS_CTL) + CW_CNT; unsigned* list = (unsigned*)(A.ws + WS_LIST);
    for (int chunk = vcu; chunk < T / 128; chunk += G) {
        if (tid < 32) lcnt[tid] = 0;
        __syncthreads();
        const int row = chunk * 128 + (wave & 3) * 32 + r32;
        int e1 = 0, e2 = 0, p1 = 0, p2 = 0; float w1 = 0.f, w2 = 0.f, rs = 0.f;
        f32x16 acc0 = {}, acc1 = {}; f32x4 sq[4];
        { const bf16* xp = x1g + (size_t)row * 1024 + hi * 8 + (wave >> 2) * 512;
            const LAS bf16* ap0 = Wl + (4 + r32) * WLS + hi * 8 + (wave >> 2) * 512; const LAS bf16* ap1 = Wl + (r32 & 3) * WLS + hi * 8 + (wave >> 2) * 512;
            bf16x8 bA[8], bB[8], bC[8], bD[8];
#define P6_LOADB(B, s0) do { _Pragma("unroll") for (int j = 0; j < 8; ++j) B[j] = *(const GAS bf16x8*)(xp + ((s0) + j) * 16); } while (0)
#define P6_MMA(B, s0) do { _Pragma("unroll") for (int j = 0; j < 8; ++j) { const bf16x8 a0 = *(const LAS bf16x8*)(ap0 + ((s0) + j) * 16); bf16x8 a1 = *(const LAS bf16x8*)(ap1 + ((s0) + j) * 16); if (r32 >= 4) a1 = (bf16x8){0, 0, 0, 0, 0, 0, 0, 0}; \
                acc0 = __builtin_amdgcn_mfma_f32_32x32x16_bf16(a0, B[j], acc0, 0, 0, 0); acc1 = __builtin_amdgcn_mfma_f32_32x32x16_bf16(a1, B[j], acc1, 0, 0, 0); } } while (0)
            P6_LOADB(bA, 0); P6_LOADB(bB, 8); P6_LOADB(bC, 16); P6_LOADB(bD, 24);
#pragma unroll
            for (int q = 0; q < 4; ++q) sq[q] = *(const GAS f32x4*)(ssqp + (size_t)row * 16 + 4 * q);
            P6_MMA(bA, 0); P6_MMA(bB, 8); P6_MMA(bC, 16); P6_MMA(bD, 24);
#undef P6_LOADB
#undef P6_MMA
        }
        if (wave >= 4) {
#pragma unroll
            for (int r = 0; r < 16; ++r) xch[((wave & 3) * 20 + r) * 64 + lane] = acc0[r];
#pragma unroll
            for (int r = 0; r < 4; ++r) xch[((wave & 3) * 20 + 16 + r) * 64 + lane] = acc1[r];
        }
        __syncthreads();
        if (wave < 4) {
#pragma unroll
            for (int r = 0; r < 16; ++r) acc0[r] += xch[(wave * 20 + r) * 64 + lane];
#pragma unroll
            for (int r = 0; r < 4; ++r) acc1[r] += xch[(wave * 20 + 16 + r) * 64 + lane];
            float el[32], gl[4];
#pragma unroll
            for (int r = 0; r < 16; ++r) { auto rr = __builtin_amdgcn_permlane32_swap(__float_as_uint(acc0[r]), __float_as_uint(acc0[r]), false, false);
                el[(r & 3) + 8 * (r >> 2)] = __uint_as_float(rr[0]); el[(r & 3) + 8 * (r >> 2) + 4] = __uint_as_float(rr[1]); }
#pragma unroll
            for (int i = 0; i < 4; ++i) { auto rr = __builtin_amdgcn_permlane32_swap(__float_as_uint(acc1[i]), __float_as_uint(acc1[i]), false, false); gl[i] = __uint_as_float(rr[0]); }
            float ss = 0.f;
#pragma unroll
            for (int q = 0; q < 4; ++q) { const f32x4 v = sq[q]; ss += (v.x + v.y) + (v.z + v.w); }
            rs = 1.0f / sqrtf(ss * (1.f / DM) + EPS);
#pragma unroll
            for (int i = 0; i < 4; ++i) gl[i] = gl[i] * rs + bgroup[i];
            int g = 0; float gmx = gl[0];
#pragma unroll
            for (int i = 1; i < 4; ++i) { const bool b = gl[i] > gmx; gmx = b ? gl[i] : gmx; g = b ? i : g; }
            float Z = 0.f;
#pragma unroll
            for (int i = 0; i < 4; ++i) Z += __expf(gl[i] - gmx);
            const float pg = 1.0f / Z;
            float v[8];
#pragma unroll
            for (int j = 0; j < 8; ++j) { const float x = (g == 0) ? el[j] : (g == 1) ? el[8 + j] : (g == 2) ? el[16 + j] : el[24 + j]; v[j] = x * rs + brouter[g * 8 + j]; }
            int i1 = 0; float m1 = v[0];
#pragma unroll
            for (int j = 1; j < 8; ++j) { const bool b = v[j] > m1; m1 = b ? v[j] : m1; i1 = b ? j : i1; }
            int i2 = 0; float m2 = -INFINITY;
#pragma unroll
            for (int j = 0; j < 8; ++j) { const bool b = (j != i1) && (v[j] > m2); m2 = b ? v[j] : m2; i2 = b ? j : i2; }
            const float tt = __expf(m2 - m1); w1 = pg / (1.0f + tt); w2 = pg * tt / (1.0f + tt);
            e1 = g * 8 + i1; e2 = g * 8 + i2;
            if (hi == 0) { p1 = __hip_atomic_fetch_add(lcnt + e1, 1, __ATOMIC_RELAXED, __HIP_MEMORY_SCOPE_WORKGROUP); p2 = __hip_atomic_fetch_add(lcnt + e2, 1, __ATOMIC_RELAXED, __HIP_MEMORY_SCOPE_WORKGROUP); }
        }
        __syncthreads();
        if (tid < 32) lbase[tid] = (int)__hip_atomic_fetch_add(cnt + tid * 16, (unsigned)lcnt[tid], RLX_AGENT);
        __syncthreads();
        if (wave < 4 && hi == 0) {
            ((v4u*)list)[(size_t)e1 * LISTCAP + lbase[e1] + p1] = (v4u){2u * row, __float_as_uint(w1), __float_as_uint(rs), 0u}; ((v4u*)list)[(size_t)e2 * LISTCAP + lbase[e2] + p2] = (v4u){2u * row + 1u, __float_as_uint(w2), __float_as_uint(rs), 0u};
        }
        __syncthreads();
    }
}

__device__ __forceinline__ int moe_prefix(LAS unsigned char* lds, const Args& A, int tid) {
    LAS int* tpre = (LAS int*)(lds + LDSCTL_OFF); LAS int* cnts = (LAS int*)(lds + LDSCTL_OFF + 160);
    unsigned* cnt = (unsigned*)(A.ws + WS_CTL) + CW_CNT;
    __syncthreads();
    if (tid < 32) cnts[tid] = (int)__hip_atomic_load(cnt + tid * 16, RLX_AGENT);
    __syncthreads();
    if (tid == 0) { int s = 0; for (int e = 0; e < NEXP; ++e) { tpre[e] = s; s += (cnts[e] + 255) >> 8; } tpre[NEXP] = s; }
    __syncthreads();
    return tpre[NEXP];
}

__device__ __forceinline__ void p9_final(const Args& A, int vcu, int G, int tid) {
    const int lane = tid & 63, wave = __builtin_amdgcn_readfirstlane(tid >> 6);
    const int gw = vcu * NWAVES + wave, NGW = G * NWAVES;
    f32x4 gv[4];
#pragma unroll
    for (int j = 0; j < 4; ++j) gv[j] = ((const GAS f32x4*)A.in[19])[lane + 64 * j];
    const bf16* x1 = (const bf16*)(A.ws + WS_H); const unsigned char* yc = (const unsigned char*)(A.ws + WS_YC);
    for (int m = gw; m < T; m += NGW) {
        const GAS u32x2* xr = (const GAS u32x2*)(x1 + (size_t)m * DM) + lane;
        const GAS unsigned* y0 = (const GAS unsigned*)(yc + (size_t)(2 * m) * DM) + lane; const GAS unsigned* y1 = (const GAS unsigned*)(yc + (size_t)(2 * m + 1) * DM) + lane;
        f32x4 v[4]; float s = 0.f;
#pragma unroll
        for (int j = 0; j < 4; ++j) { const unsigned a = y0[64 * j], b = y1[64 * j]; const u32x2 c = xr[64 * j];
            const f32x2v a01 = __builtin_amdgcn_cvt_pk_f32_fp8((int)a, false), a23 = __builtin_amdgcn_cvt_pk_f32_fp8((int)a, true), b01 = __builtin_amdgcn_cvt_pk_f32_fp8((int)b, false), b23 = __builtin_amdgcn_cvt_pk_f32_fp8((int)b, true);
            v[j].x = bf2f_lo(c.x) + (a01.x + b01.x) * 0.0625f; v[j].y = bf2f_hi(c.x) + (a01.y + b01.y) * 0.0625f; v[j].z = bf2f_lo(c.y) + (a23.x + b23.x) * 0.0625f; v[j].w = bf2f_hi(c.y) + (a23.y + b23.y) * 0.0625f;
            s += (v[j].x * v[j].x + v[j].y * v[j].y) + (v[j].z * v[j].z + v[j].w * v[j].w); }
        const float rstd = 1.0f / sqrtf(wave_sum(s) * (1.f / DM) + EPS);
        GAS f32x4* o = (GAS f32x4*)(A.out + (size_t)m * DM) + lane;
#pragma unroll
        for (int j = 0; j < 4; ++j) o[64 * j] = v[j] * rstd * gv[j];
    }
}

__global__ void __launch_bounds__(NWAVES * 64, 2) mk_fwd(Args args) {
    extern __shared__ __attribute__((aligned(16))) unsigned char lds[];
    LAS unsigned char* L = (LAS unsigned char*)lds;
    volatile LAS unsigned* MISC = (volatile LAS unsigned*)(L + MISC_OFF);
    const int tid = threadIdx.x;
    const int G = gridDim.x; const int bx = blockIdx.x; const int vcu = (G % 8 == 0) ? (bx % 8) * (G / 8) + bx / 8 : bx;
    unsigned char* ws = args.ws;
    gu32* ctl = (gu32*)(ws + WS_CTL);
    for (int u = tid; u < (LDS_BYTES - LDSCTL_OFF) / 4; u += NWAVES * 64) ((LAS unsigned*)(L + LDSCTL_OFF))[u] = 0u;
    __syncthreads();
    XcdBarrier bar; bar.bar = (unsigned*)(ctl + CW_BAR); bar.x = 0; bar.st = nullptr;
    if (N_LAUNCHES == 1) bar = xcd_barrier_post((unsigned*)(ctl + CW_BAR), MISC + 8);
    const int lo = args.ph_lo, hi = args.ph_hi;
#ifndef PH_MASK
#define PH_MASK 0x3ff
#endif
#define IN(k) (((PH_MASK >> (k)) & 1) && lo <= (k) && (k) < hi)
#define BOTH(k) (IN(k) && IN((k) + 1))
#ifndef DUPBAR
#define DUPBAR 0
#endif
#define GRID_BAR() do { if (N_LAUNCHES == 1) { xcd_barrier(bar); if (DUPBAR) xcd_barrier(bar); } } while (0)
#ifndef DUP_MASK
#define DUP_MASK 0
#endif
#define NREP(k) (1 + ((DUP_MASK >> (k)) & 1))

#define DUP(k) ((DUP_MASK >> (k)) & 1)
#ifndef DUP2_MOBA
#define DUP2_MOBA 0
#endif
#ifndef STAG5
#define STAG5 0
#endif
#ifndef STAG4
#define STAG4 0
#endif
#define STAG_WAIT(ticks) do { if ((ticks) > 0 && (vcu & 1)) { const unsigned long long t0_ = __builtin_amdgcn_s_memrealtime(); while (__builtin_amdgcn_s_memrealtime() - t0_ < (unsigned long long)(ticks)) __builtin_amdgcn_s_sleep(8); } } while (0)
#ifndef SHADOWS
#define SHADOWS 4
#endif
    const int nsh = (N_LAUNCHES == 1 && lo == 0 && hi == N_PHASES && (SHADOWS)) ? 4 : 0;
#define GRID_BAR_SH(s) do { if (N_LAUNCHES == 1) { if ((s) < nsh) xcd_barrier_work(bar, [&](int t, int) { p0_shadow(L, args, vcu, G, (s), t); }); else xcd_barrier(bar); } } while (0)
#define P0_BODY p0_prologue(L, args, vcu, G, tid, nsh)
    if (IN(0)) { P0_BODY; if (DUP(0)) { GRID_BAR(); P0_BODY; } if (BOTH(0)) GRID_BAR_SH(0); }

#define P1_BF16 do { pg8::Gemm g{(const pg8::bf16_t*)(ws + WS_H), (const pg8::bf16_t*)(ws + WS_WIN), T, INC, DM}; pg8::SubOrder<0> S; S.init(T, G, bx);       \
          pg8::gemm_phase<pg8::EpiProj, pg8::SubOrder<0>, true, false>(L + RING_OFF, g, S, E); } while (0)
#define P1_FP8 do { pg8::Gemm g{(const pg8::bf16_t*)(ws + WS_H8), (const pg8::bf16_t*)(ws + WS_WIN8), T, INC, DM / 2, nullptr, nullptr, 0x79797979}; pg8::SubOrder<1> S; S.init(T, G, bx);     \
          pg8::gemm_phase<pg8::EpiProj, pg8::SubOrder<1>, true, false, false, true>(L + RING_OFF, g, S, E); } while (0)
#define P1_BODY do { pg8::EpiProj E{(pg8::bf16_t*)(ws + WS_R6), (pg8::bf16_t*)(ws + WS_GATES), (const float*)(ws + WS_ROPE), (const float*)(ws + WS_ROPE) + SEQ * 32, (float*)(ws + WS_KPART)}; \
        if constexpr (pg8::P1_NB > 0) { P1_BF16; } P1_FP8; } while (0)
#ifndef DUP1_PART
#define DUP1_PART 0
#endif
    if (IN(1)) { P1_BODY; if (DUP(1)) { GRID_BAR(); pg8::EpiProj E{(pg8::bf16_t*)(ws + WS_R6), (pg8::bf16_t*)(ws + WS_GATES), (const float*)(ws + WS_ROPE), (const float*)(ws + WS_ROPE) + SEQ * 32, (float*)(ws + WS_KPART)};
            if (DUP1_PART == 1) { P1_BF16; } else if (DUP1_PART == 2) { P1_FP8; } else { P1_BF16; P1_FP8; } } if (BOTH(1)) GRID_BAR_SH(1); }

    if (IN(2)) { p2_attention<true, true>((char*)lds + RING_OFF, ws, vcu, G, nullptr, (const float*)(ws + WS_ROPE) + 2 * SEQ * 32, args.in[10]);
        if (DUP(2)) { GRID_BAR(); p2_attention<DUP2_MOBA != 0, DUP2_MOBA == 0>((char*)lds + RING_OFF, ws, vcu, G, (void*)args.out, (const float*)(ws + WS_ROPE) + 2 * SEQ * 32, args.in[10]); } if (BOTH(2)) GRID_BAR_SH(2); }

    if (IN(3)) { }

#ifndef P4_TWOPASS
#define P4_TWOPASS 0
#endif
#if P4_TWOPASS
#define P4_BODY do { pg8::StaticOrder S; S.init(T, DM, G, bx); \
        { pg8::Gemm g{(const pg8::bf16_t*)(ws + WS_OA), (const pg8::bf16_t*)(ws + WS_WBM), T, DM, 512}; \
          pg8::EpiMerge<0> E{(pg8::bf16_t*)(ws + WS_MERGED), (const pg8::bf16_t*)(ws + WS_GATES)}; \
          pg8::gemm_phase<pg8::EpiMerge<0>, pg8::StaticOrder, true, false>(L + RING_OFF, g, S, E); } \
        { pg8::Gemm g{(const pg8::bf16_t*)(ws + WS_ODF), (const pg8::bf16_t*)(ws + WS_WBD), T, DM, 512}; \
          pg8::EpiMerge<1> E{(pg8::bf16_t*)(ws + WS_MERGED), (const pg8::bf16_t*)(ws + WS_GATES)}; \
          pg8::gemm_phase<pg8::EpiMerge<1>, pg8::StaticOrder, true, false>(L + RING_OFF, g, S, E); } } while (0)
#else
#define P4_BODY do { STAG_WAIT(STAG4); pg8::StaticOrder S; S.init(T, DM, G, bx); \
        pg8::Gemm g{(const pg8::bf16_t*)(ws + WS_OA), (const pg8::bf16_t*)(ws + WS_WBM), T, DM, 512, (const pg8::bf16_t*)(ws + WS_ODF), (const pg8::bf16_t*)(ws + WS_WBD)}; \
        pg8::EpiMerge2 E{(pg8::bf16_t*)(ws + WS_MERGED), (const pg8::bf16_t*)(ws + WS_GATES)}; \
        pg8::gemm_phase<pg8::EpiMerge2, pg8::StaticOrder, true, false, true>(L + RING_OFF, g, S, E); } while (0)
#endif
    if (IN(4)) { P4_BODY; if (DUP(4)) { GRID_BAR(); P4_BODY; } if (BOTH(4)) GRID_BAR_SH(3); }

#define P5_BODY do { STAG_WAIT(STAG5); pg8::Gemm g{(const pg8::bf16_t*)(ws + WS_MERGED), (const pg8::bf16_t*)(ws + WS_WOUT), T, DM, DM}; pg8::StaticOrder S; S.init(T, DM, G, bx); \
        pg8::EpiRes E{args.in[0], (pg8::bf16_t*)(ws + WS_H), (float*)(ws + WS_SSQP), (unsigned char*)(ws + WS_X1F8)}; \
        pg8::gemm_phase<pg8::EpiRes, pg8::StaticOrder, true, false>(L + RING_OFF, g, S, E); } while (0)
    bool p6_prepped = false;
#ifndef DUP5_NULL
#define DUP5_NULL 0
#endif
#define P5_NULL_BODY do { pg8::Gemm g{(const pg8::bf16_t*)(ws + WS_MERGED), (const pg8::bf16_t*)(ws + WS_WOUT), T, DM, DM}; pg8::StaticOrder S; S.init(T, DM, G, bx); \
        pg8::EpiNull E{(float*)(ws + WS_SSQP)}; \
        pg8::gemm_phase<pg8::EpiNull, pg8::StaticOrder, true, false>(L + RING_OFF, g, S, E); } while (0)
    if (IN(5)) { P5_BODY; if (DUP(5)) { GRID_BAR(); if (DUP5_NULL) { P5_NULL_BODY; } else { P5_BODY; } }
        if (BOTH(5) && N_LAUNCHES == 1) { xcd_barrier_work(bar, [&](int t, int n) { p6_prep(L + RING_OFF, args, t, n); }); p6_prepped = true; } }

    if (IN(6)) { p6_router(L + RING_OFF, args, vcu, G, tid, p6_prepped); if (BOTH(6)) GRID_BAR(); }

#define P7_BODY do { const int ntile = __builtin_amdgcn_readfirstlane(moe_prefix(L, args, tid)); moe_nt = ntile; \
        pg8::Gemm g{(const pg8::bf16_t*)(ws + WS_X1F8), (const pg8::bf16_t*)(ws + WS_W13), T, 1024, DM / 2, nullptr, nullptr, 0x79797979}; \
        pg8::MoeOrder S{(const LAS int*)(L + LDSCTL_OFF), (const LAS int*)(L + LDSCTL_OFF + 160), (const unsigned*)(ws + WS_LIST), G, vcu, 4 * ntile, 1, 1024u}; \
        pg8::EpiAct E{(unsigned char*)(ws + WS_ACT), (const unsigned*)(ws + WS_LIST)}; \
        pg8::gemm_phase<pg8::EpiAct, pg8::MoeOrder, true, true, false, true>(L + RING_OFF, g, S, E); } while (0)
    int moe_nt = 256;
    if (IN(7)) { P7_BODY; if (DUP(7)) { GRID_BAR(); P7_BODY; }
        if (nsh > 0) p0_tail_w2(L, args, vcu, G, 4 * moe_nt, tid);
        if (BOTH(7)) GRID_BAR(); }

#define P8_BODY do { const int ntile = __builtin_amdgcn_readfirstlane(moe_prefix(L, args, tid)); \
        pg8::Gemm g{(const pg8::bf16_t*)(ws + WS_ACT), (const pg8::bf16_t*)(ws + WS_W2), 2 * T, 1024, 256, nullptr, nullptr, 0x7a7a7a7a}; \
        pg8::MoeOrder S{(const LAS int*)(L + LDSCTL_OFF), (const LAS int*)(L + LDSCTL_OFF + 160), (const unsigned*)(ws + WS_LIST), G, vcu, 4 * ntile, 0, 512u}; \
        pg8::EpiDown E{(unsigned char*)(ws + WS_YC), (const unsigned*)(ws + WS_LIST)}; \
        pg8::gemm_phase<pg8::EpiDown, pg8::MoeOrder, true, true, false, true>(L + RING_OFF, g, S, E); } while (0)
    if (IN(8)) { P8_BODY; if (DUP(8)) { GRID_BAR(); P8_BODY; } if (BOTH(8)) GRID_BAR(); }

    if (IN(9)) { p9_final(args, vcu, G, tid); if (DUP(9)) { GRID_BAR(); p9_final(args, vcu, G, tid); } }
#undef IN
#undef BOTH
#undef GRID_BAR
}

extern "C" void kernel_launch(void* const* d_in, const int* in_sizes, int n_in, void* d_out, int out_size, void* d_ws, size_t ws_size, hipStream_t stream) {
    static int grid = 0;
    if (grid == 0) {
        if (n_in != 20 || in_sizes[0] != T * DM || out_size != T * DM || ws_size < WS_END) { fprintf(stderr, "kernel_launch: built for 20 inputs, x/out of %d floats, >= %zu bytes of workspace; got n_in %d, in0 %d, out %d, ws %zu; nothing launched\n", T * DM, (size_t)WS_END, n_in, n_in > 0 ? in_sizes[0] : -1, out_size, ws_size); grid = -1; return; }
        int dev = 0, cus = 0, per_cu = 0;
        if (hipGetDevice(&dev) != hipSuccess || hipDeviceGetAttribute(&cus, hipDeviceAttributeMultiprocessorCount, dev) != hipSuccess) { fprintf(stderr, "kernel_launch: hipGetDevice / hipDeviceGetAttribute failed; nothing launched\n"); grid = -1; return; }
        if (hipFuncSetAttribute((const void*)mk_fwd, hipFuncAttributeMaxDynamicSharedMemorySize, LDS_BYTES) != hipSuccess) { fprintf(stderr, "kernel_launch: hipFuncSetAttribute failed; nothing launched\n"); grid = -1; return; }
        if (hipOccupancyMaxActiveBlocksPerMultiprocessor(&per_cu, (const void*)mk_fwd, NWAVES * 64, LDS_BYTES) != hipSuccess || per_cu < 1)
            fprintf(stderr, "kernel_launch: note: the occupancy query reports %d workgroups per CU\n", per_cu);
        (void)hipGetLastError();
        grid = cus;
    }
    if (grid < 0) return;
    if (hipMemsetAsync((char*)d_ws + WS_CTL, 0, CTL_ZERO_BYTES, stream) != hipSuccess) { fprintf(stderr, "kernel_launch: hipMemsetAsync of the control words failed; nothing launched\n"); return; }
    Args a{};
    for (int i = 0; i < 20; ++i) a.in[i] = (const float*)d_in[i];
    a.out = (float*)d_out; a.ws = (unsigned char*)d_ws;
    for (int li = 0; li < N_LAUNCHES; ++li) {
        a.ph_lo = (N_LAUNCHES == 1) ? 0 : li; a.ph_hi = (N_LAUNCHES == 1) ? N_PHASES : li + 1;
        hipLaunchKernelGGL(mk_fwd, dim3(grid), dim3(NWAVES * 64), LDS_BYTES, stream, a);
        const hipError_t le = hipPeekAtLastError();
        if (le != hipSuccess) { fprintf(stderr, "kernel_launch: launch %d failed: %s\n", li, hipGetErrorName(le)); break; }
    }
}
```

```cpp
#include <hip/hip_runtime.h>
#include <hip/hip_bf16.h>
#include <cstdio>
#include <cstdint>
#include <cmath>

#define WGM_SET 4
#ifndef MK_N_LAUNCHES
#define MK_N_LAUNCHES 1
#endif

constexpr int BATCH = 16, SEQ = 2048, T = BATCH * SEQ, DM = 1024, INC = 5120;
constexpr int NEXP = 32, DEXP = 512, LISTCAP = 32768;
constexpr float EPS = 1e-6f;
constexpr float C2 = 0.125f * 1.4426950408889634f;

namespace pg8 {
#define PG8_LAS __attribute__((address_space(3)))
typedef unsigned short bf16_t;
typedef short bf16x8 __attribute__((ext_vector_type(8)));
typedef float f32x4 __attribute__((ext_vector_type(4)));
typedef unsigned u32x4 __attribute__((ext_vector_type(4)));
typedef int i32x4 __attribute__((ext_vector_type(4)));
typedef unsigned u32x2 __attribute__((ext_vector_type(2)));
#ifndef WGM_SET
#define WGM_SET 8
#endif
constexpr int BM = 256, BK = 64, HALF = 128, HTB = HALF * BK * 2  , STAGE_BYTES = 8 * HTB, NXCD = 8, WGM = WGM_SET;

__host__ __device__ __forceinline__ int lds_byte(int r, int c) { const int st = (r >> 4) * 2 + (c >> 5), rr = r & 15, cc = c & 31, ob = rr * 64 + cc * 2; return st * 1024 + (ob ^ (((ob >> 9) & 1) << 5)); }
__host__ __device__ __forceinline__ void stage_rc(int b, int& R, int& C) { const int st = b / 1024, sb = b % 1024, swz = sb ^ (((sb >> 9) & 1) << 5); R = (st >> 1) * 16 + swz / 64; C = (st & 1) * 32 + (swz % 64) / 2; }
__host__ __device__ __forceinline__ int permB(int R) { return 64 * ((R >> 5) & 3) + 16 * ((R & 15) >> 2) + 4 * ((R >> 4) & 1) + (R & 3); }
__host__ __device__ __forceinline__ int perm32(int rho) { const int n = rho >> 4, i = rho & 15; return 8 * (i >> 2) + 4 * n + (i & 3); }

struct Unit { int pm, pn, e, ti, cnt; };
struct Gemm { const bf16_t* A; const bf16_t* Bt; int M, N, K; const bf16_t* A2; const bf16_t* Bt2; int wscale; };

struct StaticOrder {
    int nM, nN, nwg, G, c;
    __host__ __device__ void init(int M, int N, int G_, int c_) { nM = M / BM; nN = N / BM; nwg = nM * nN; G = G_; c = c_; }
    __host__ __device__ bool next(int i, Unit& u) const {
        const long L = (long)i * G + c; if (L >= nwg) return false;
        int wgid = (int)L; { const int q = nwg / NXCD, r = nwg % NXCD, xcd = wgid % NXCD, off = wgid / NXCD; wgid = (xcd < r ? xcd * (q + 1) : r * (q + 1) + (xcd - r) * q) + off; }
        const int nig = WGM * nN, gid = wgid / nig, fm = gid * WGM, gsz = (nM - fm) < WGM ? (nM - fm) : WGM;
        u.pm = fm + ((wgid % nig) % gsz); u.pn = (wgid % nig) / gsz; u.e = 0; u.ti = 0; u.cnt = 0; return true;
    }
    __device__ __forceinline__ unsigned arow(const Unit&, int) const { return 0u; }
    __device__ __forceinline__ void a_ready(const Unit&) const {}
    __device__ __forceinline__ void done(const Unit&) const {}
};

#ifndef P1_NBF
#define P1_NBF 6
#endif
constexpr int P1_NB = P1_NBF;
template <int MODE> struct SubOrder {
    StaticOrder S;
    __device__ void init(int M, int G_, int c_) { S.init(M, (MODE == 0 ? P1_NB : 20 - P1_NB) * BM, G_, c_); }
    __device__ bool next(int i, Unit& u) const { if (!S.next(i, u)) return false; u.pn = (MODE == 0) ? u.pn + 6 : (u.pn < 6 ? u.pn : u.pn + P1_NB); return true; }
    __device__ __forceinline__ unsigned arow(const Unit&, int) const { return 0u; }
    __device__ __forceinline__ void a_ready(const Unit&) const {}
    __device__ __forceinline__ void done(const Unit&) const {}
};

typedef float f32x2 __attribute__((ext_vector_type(2))); typedef __bf16 bf16x2v __attribute__((ext_vector_type(2)));
__device__ __forceinline__ unsigned cvt_pk_bf16(float lo, float hi) { f32x2 v = {lo, hi}; bf16x2v b = __builtin_convertvector(v, bf16x2v); return __builtin_bit_cast(unsigned, b); }
__device__ __forceinline__ u32x4 pack8(const f32x4 a, const f32x4 b) { u32x4 w; w.x = cvt_pk_bf16(a[0], a[1]); w.y = cvt_pk_bf16(a[2], a[3]); w.z = cvt_pk_bf16(b[0], b[1]); w.w = cvt_pk_bf16(b[2], b[3]); return w; }
__device__ __forceinline__ u32x2 pack8_fp8(const f32x4 a, const f32x4 b) { int lo = 0, hi = 0; lo = __builtin_amdgcn_cvt_pk_fp8_f32(a[0], a[1], lo, false); lo = __builtin_amdgcn_cvt_pk_fp8_f32(a[2], a[3], lo, true);
    hi = __builtin_amdgcn_cvt_pk_fp8_f32(b[0], b[1], hi, false); hi = __builtin_amdgcn_cvt_pk_fp8_f32(b[2], b[3], hi, true); return (u32x2){(unsigned)lo, (unsigned)hi}; }
__device__ __forceinline__ float bflo(unsigned w) { return __builtin_bit_cast(float, w << 16); }
__device__ __forceinline__ float bfhi(unsigned w) { return __builtin_bit_cast(float, w & 0xffff0000u); }
__device__ __forceinline__ void unpack8(const u32x4 w, f32x4& a, f32x4& b) { a = (f32x4){bflo(w.x), bfhi(w.x), bflo(w.y), bfhi(w.y)}; b = (f32x4){bflo(w.z), bfhi(w.z), bflo(w.w), bfhi(w.w)}; }
__device__ __forceinline__ float sigmoidf_(float x) { return __builtin_amdgcn_rcpf(1.0f + __builtin_amdgcn_exp2f(-1.4426950408889634f * x)); }

template <class Epi, class Sched, bool ALIGN_EPI, bool GATHER, bool DUAL = false, bool FP8 = false>
__device__ __forceinline__ void gemm_phase(PG8_LAS unsigned char* lds, const Gemm g, const Sched& S, const Epi& E) {
    const int tid = threadIdx.x, wid = __builtin_amdgcn_readfirstlane(tid >> 6), lane = tid & 63, wr = wid >> 2, wc = wid & 3, fr = lane & 15, fq = lane >> 4;
    const int wscale = g.wscale, ascale = 0x7f7f7f7f;
    const int K = g.K, nt = DUAL ? 2 * (K / BK) : K / BK, nth = K / BK;
    unsigned voffA[2], voffB[2]; int rowA[2]; unsigned colA[2];
#pragma unroll
    for (int i = 0; i < 2; ++i) { int R, C; stage_rc(tid * 16 + i * 8192, R, C); const int Rb = permB(R);
        voffA[i] = (unsigned)(R * K + C) * 2u; voffB[i] = (unsigned)(Rb * K + C) * 2u; rowA[i] = R; colA[i] = (unsigned)C * 2u; }
    const size_t kstep = (size_t)(BK * 2);
    const size_t hstep = (size_t)HALF * K * 2;
    const size_t hstepB = (size_t)8 * K * 2;
    const size_t tstep = 2 * hstep;
    const unsigned ldsw = (unsigned)wid * 1024u;
    const int aoff = lds_byte(wr * 64 + fr, fq * 8), boff = lds_byte(wc * 32 + fr, fq * 8);
#define PG8_SA(b, h) (((b) * 2 + (h)) * HTB)
#define PG8_SB(b, h) ((4 + (b) * 2 + (h)) * HTB)
#define PG8_STAGE(bufoff, gbase, voff) do { _Pragma("unroll") for (int _i = 0; _i < 2; ++_i) \
        __builtin_amdgcn_global_load_lds((const unsigned*)((const char*)(gbase) + (voff)[_i]), (PG8_LAS unsigned*)(lds + (bufoff) + ldsw + _i * 8192), 16, 0, 0); } while (0)
#define PG8_STAGE_A(bufoff, ptr, H, ARR0, ARR1) do { if constexpr (GATHER) { if (H) PG8_STAGE(bufoff, ptr, ARR1); else PG8_STAGE(bufoff, ptr, ARR0); } else { PG8_STAGE(bufoff, (ptr) + (H) * hstep, voffA); } } while (0)
#define PG8_LDA(dst, b, h) do { _Pragma("unroll") for (int m = 0; m < 4; ++m) _Pragma("unroll") for (int k = 0; k < 2; ++k) dst[m][k] = *(const PG8_LAS bf16x8*)(lds + PG8_SA(b, h) + aoff + m * 2048 + k * 1024); } while (0)
#define PG8_LDB(dst, b, h) do { _Pragma("unroll") for (int n = 0; n < 2; ++n) _Pragma("unroll") for (int k = 0; k < 2; ++k) dst[n][k] = *(const PG8_LAS bf16x8*)(lds + PG8_SB(b, h) + boff + n * 2048 + k * 1024); } while (0)
#define PG8_CAT(x) __builtin_shufflevector(__builtin_bit_cast(i32x4, (x)[0]), __builtin_bit_cast(i32x4, (x)[1]), 0, 1, 2, 3, 4, 5, 6, 7)
#define PG8_MMA(ai, bj, At, Bt) do { __builtin_amdgcn_s_setprio(1); if constexpr (FP8) { _Pragma("unroll") for (int m = 0; m < 4; ++m) _Pragma("unroll") for (int n = 0; n < 2; ++n) \
        asm volatile("v_mfma_scale_f32_16x16x128_f8f6f4 %0, %1, %2, %0, %3, %4 op_sel_hi:[0,0,0]" : "+v"(acc[ai][bj][m][n]) : "v"(PG8_CAT(Bt[n])), "v"(PG8_CAT(At[m])), "v"(wscale), "v"(ascale)); } \
        else { _Pragma("unroll") for (int m = 0; m < 4; ++m) _Pragma("unroll") for (int n = 0; n < 2; ++n) _Pragma("unroll") for (int k = 0; k < 2; ++k) \
        acc[ai][bj][m][n] = __builtin_amdgcn_mfma_f32_16x16x32_bf16(Bt[n][k], At[m][k], acc[ai][bj][m][n], 0, 0, 0); } __builtin_amdgcn_s_setprio(0); } while (0)
#define PG8_WAIT_V(n) asm volatile("s_waitcnt vmcnt(" #n ")" ::: "memory")
#define PG8_WAIT_L(n) asm volatile("s_waitcnt lgkmcnt(" #n ")" ::: "memory")
#define PG8_BAR __builtin_amdgcn_s_barrier()
#define PG8_SCHED __builtin_amdgcn_sched_barrier(0)
    Unit cur, nxt; int ui = 0;
    if (!S.next(0, cur)) return;
    f32x4 acc[2][2][4][2];
#define PG8_ZERO_ACC() do { _Pragma("unroll") for (int a = 0; a < 2; ++a) _Pragma("unroll") for (int b = 0; b < 2; ++b) _Pragma("unroll") for (int m = 0; m < 4; ++m) _Pragma("unroll") for (int n = 0; n < 2; ++n) { \
        f32x2 lo_, hi_; asm volatile("v_mov_b64 %0, 0" : "=v"(lo_)); asm volatile("v_mov_b64 %0, 0" : "=v"(hi_)); acc[a][b][m][n] = __builtin_shufflevector(lo_, hi_, 0, 1, 2, 3); } } while (0)
    PG8_ZERO_ACC();
    bf16x8 At[4][2], B0[2][2], B1[2][2];
    float ef[8];
    unsigned ea[8];
    unsigned v0[2] = {0u, 0u}, v1[2] = {0u, 0u}, nv0[2] = {0u, 0u}, nv1[2] = {0u, 0u};
    const char* cA = GATHER ? (const char*)g.A : (const char*)g.A + (size_t)cur.pm * tstep; const char* cB = (const char*)g.Bt + (size_t)cur.pn * tstep;
    const char* cA2 = DUAL ? (const char*)g.A2 + (size_t)cur.pm * tstep : cA; const char* cB2 = DUAL ? (const char*)g.Bt2 + (size_t)cur.pn * tstep : cB;
#define PG8_KT(a, a2, j) ((DUAL && (j) >= nth) ? (a2) + (size_t)((j) - nth) * kstep : (a) + (size_t)(j) * kstep)
    if constexpr (GATHER) {
#pragma unroll
        for (int i = 0; i < 2; ++i) { v0[i] = S.arow(cur, rowA[i]) + colA[i]; v1[i] = S.arow(cur, HALF + rowA[i]) + colA[i]; }
    }
    S.a_ready(cur);
    PG8_STAGE(PG8_SB(0, 0), cB, voffB); PG8_STAGE(PG8_SB(0, 1), cB + hstepB, voffB); PG8_STAGE_A(PG8_SA(0, 0), cA, 0, v0, v1); PG8_STAGE_A(PG8_SA(0, 1), cA, 1, v0, v1);
    if (wr == 1) PG8_BAR;
    PG8_WAIT_V(2); PG8_BAR;
    PG8_STAGE(PG8_SB(1, 0), cB + kstep, voffB); PG8_STAGE_A(PG8_SA(1, 0), cA + kstep, 0, v0, v1); PG8_STAGE(PG8_SB(1, 1), cB + hstepB + kstep, voffB);
    PG8_WAIT_V(6); PG8_BAR;
    for (;;) {
        const bool has_next = S.next(ui + 1, nxt);
        const char* nA = GATHER ? cA : (has_next ? (const char*)g.A + (size_t)nxt.pm * tstep : cA); const char* nB = has_next ? (const char*)g.Bt + (size_t)nxt.pn * tstep : cB;
        if constexpr (GATHER) {
            if (has_next) {
#pragma unroll
                for (int i = 0; i < 2; ++i) { nv0[i] = S.arow(nxt, rowA[i]) + colA[i]; nv1[i] = S.arow(nxt, HALF + rowA[i]) + colA[i]; }
            } else {
#pragma unroll
                for (int i = 0; i < 2; ++i) { nv0[i] = v0[i]; nv1[i] = v1[i]; }
            }
        }
        if constexpr (GATHER) E.prefetch(cur, wr, fr, ea, ef);
#pragma nounroll
        for (int t = 0; t < nt; t += 2) {
            const bool last = (t == nt - 2);
            const char* a1 = PG8_KT(cA, cA2, t + 1);
            const char* a2 = last ? nA : PG8_KT(cA, cA2, t + 2); const char* b2 = last ? nB : PG8_KT(cB, cB2, t + 2);
            const char* a3 = a2 + kstep; const char* b3 = b2 + kstep;
            unsigned w0[2], w1[2];
#pragma unroll
            for (int i = 0; i < 2; ++i) { w0[i] = last ? nv0[i] : v0[i]; w1[i] = last ? nv1[i] : v1[i]; }
            if (last && has_next) S.a_ready(nxt);
            if constexpr (DUAL) { if (t == nth) E.mid(acc, cur, wr, wc, fr, fq); }
            PG8_LDB(B0, 0, 0); PG8_LDB(B1, 0, 1); PG8_SCHED; PG8_LDA(At, 0, 0); PG8_STAGE_A(PG8_SA(1, 1), a1, 1, v0, v1);
            PG8_WAIT_V(8); PG8_WAIT_L(0); PG8_BAR; PG8_MMA(0, 0, At, B0); PG8_MMA(0, 1, At, B1); PG8_BAR; PG8_SCHED;
            PG8_LDA(At, 0, 1); PG8_STAGE(PG8_SB(0, 0), b2, voffB); PG8_STAGE(PG8_SB(0, 1), b2 + hstepB, voffB); PG8_STAGE_A(PG8_SA(0, 0), a2, 0, w0, w1);
            PG8_WAIT_V(8); PG8_WAIT_L(0); PG8_BAR; PG8_MMA(1, 0, At, B0); PG8_MMA(1, 1, At, B1); PG8_BAR; PG8_SCHED;
            PG8_LDB(B0, 1, 0); PG8_LDB(B1, 1, 1); PG8_SCHED; PG8_LDA(At, 1, 0); PG8_STAGE_A(PG8_SA(0, 1), a2, 1, w0, w1);
            PG8_WAIT_V(8); PG8_WAIT_L(0); PG8_BAR; PG8_MMA(0, 0, At, B0); PG8_MMA(0, 1, At, B1); PG8_BAR; PG8_SCHED;
            PG8_LDA(At, 1, 1); PG8_STAGE(PG8_SB(1, 0), b3, voffB); PG8_STAGE(PG8_SB(1, 1), b3 + hstepB, voffB); PG8_STAGE_A(PG8_SA(1, 0), a3, 0, w0, w1);
            PG8_WAIT_V(8); PG8_WAIT_L(0); PG8_BAR; PG8_MMA(1, 0, At, B0); PG8_MMA(1, 1, At, B1); PG8_BAR; PG8_SCHED;
        }
        if constexpr (ALIGN_EPI) { if (wr == 0) PG8_BAR; }
        if constexpr (FP8) asm volatile("s_nop 15\n\ts_nop 7" ::: "memory");
        if constexpr (GATHER) E(acc, cur, wr, wc, fr, fq, ea, ef); else E(acc, cur, wr, wc, fr, fq);
        S.done(cur);
        if (!has_next) break;
        PG8_ZERO_ACC();
        cur = nxt; cA = nA; cB = nB; ++ui;
        if constexpr (DUAL) { cA2 = (const char*)g.A2 + (size_t)cur.pm * tstep; cB2 = (const char*)g.Bt2 + (size_t)cur.pn * tstep; }
        if constexpr (GATHER) {
#pragma unroll
            for (int i = 0; i < 2; ++i) { v0[i] = nv0[i]; v1[i] = nv1[i]; }
        }
        if constexpr (ALIGN_EPI) { if (wr == 1) PG8_BAR; }
    }
    PG8_WAIT_V(0);
    if constexpr (!ALIGN_EPI) { if (wr == 0) PG8_BAR; }
    PG8_BAR;
#undef PG8_KT
#undef PG8_SA
#undef PG8_SB
#undef PG8_STAGE
#undef PG8_STAGE_A
#undef PG8_LDA
#undef PG8_LDB
#undef PG8_MMA
#undef PG8_ZERO_ACC
#undef PG8_CAT
#undef PG8_WAIT_V
#undef PG8_WAIT_L
#undef PG8_BAR
#undef PG8_SCHED
}

#define EPI_ROWLOOP _Pragma("unroll") for (int ai = 0; ai < 2; ++ai) _Pragma("unroll") for (int m = 0; m < 4; ++m)

struct EpiProj {
    bf16_t* reg6;
    bf16_t* gates;
    const float* cosT; const float* sinT;
    float* kpart;
    __device__ __forceinline__ void operator()(const f32x4 (&acc)[2][2][4][2], const Unit& u, int wr, int wc, int fr, int fq) const {
        const int pn = u.pn, row0 = u.pm * BM + wr * 64 + fr;
        if (pn >= 12) {
            const int col0 = (pn - 12) * 256 + wc * 64 + 16 * fq; const bool br1 = pn >= 16;
            unsigned char* g8 = (unsigned char*)gates;
            EPI_ROWLOOP { unsigned char* rowp = g8 + (size_t)(row0 + ai * HALF + m * 16) * 2048 + col0; u32x4 w;
#pragma unroll
                for (int bj = 0; bj < 2; ++bj) { const f32x4 a = acc[ai][bj][m][0], b = acc[ai][bj][m][1]; unsigned lo = 0u, hi = 0u;
#pragma unroll
                    for (int i = 0; i < 4; ++i) { float da = __builtin_fmaf(__builtin_amdgcn_exp2f(a[i]), 1.0f / 255.0f, 1.0f / 255.0f), db = __builtin_fmaf(__builtin_amdgcn_exp2f(b[i]), 1.0f / 255.0f, 1.0f / 255.0f);
                        if (br1) { da = __builtin_fminf(__builtin_fmaxf(da, 0.0f), 1.0f); db = __builtin_fminf(__builtin_fmaxf(db, 0.0f), 1.0f); }
                        lo = __builtin_amdgcn_cvt_pk_u8_f32(__builtin_amdgcn_rcpf(da), i, lo); hi = __builtin_amdgcn_cvt_pk_u8_f32(__builtin_amdgcn_rcpf(db), i, hi); }
                    w[2 * bj] = lo; w[2 * bj + 1] = hi; }
                __builtin_nontemporal_store(w, (u32x4*)rowp); }
            return;
        }
        const int rg = pn >> 1, pl = pn & 1;
        bf16_t* dst = reg6 + (size_t)rg * ((size_t)T * 512);
        if (rg == 2 || rg == 5) {
            const int col0 = pl * 256 + wc * 64 + 16 * fq;
            EPI_ROWLOOP { bf16_t* rowp = dst + (size_t)(row0 + ai * HALF + m * 16) * 512 + col0;
#pragma unroll
                for (int bj = 0; bj < 2; ++bj) *(u32x4*)(rowp + bj * 8) = pack8(acc[ai][bj][m][0], acc[ai][bj][m][1]); }
            return;
        }
        const float sc = (rg == 0 || rg == 3) ? C2 : 1.0f;
        const int col0 = (pl * 4 + wc) * 64 + 8 * fq;
        f32x4 ks[4] = {{0.f, 0.f, 0.f, 0.f}, {0.f, 0.f, 0.f, 0.f}, {0.f, 0.f, 0.f, 0.f}, {0.f, 0.f, 0.f, 0.f}};
#pragma unroll
        for (int aim = 0; aim < 8; aim += 2) {
        f32x4 tc0[2], tc1[2], ts0[2], ts1[2];
#pragma unroll
        for (int q = 0; q < 2; ++q) { const int s = (row0 + ((aim + q) >> 2) * HALF + ((aim + q) & 3) * 16) & (SEQ - 1);
            tc0[q] = *(const f32x4*)(cosT + s * 32 + 8 * fq); tc1[q] = *(const f32x4*)(cosT + s * 32 + 8 * fq + 4); ts0[q] = *(const f32x4*)(sinT + s * 32 + 8 * fq); ts1[q] = *(const f32x4*)(sinT + s * 32 + 8 * fq + 4); }
#pragma unroll
        for (int q = 0; q < 2; ++q) { const int ai = (aim + q) >> 2, m = (aim + q) & 3, row = row0 + ai * HALF + m * 16;
            const f32x4 c0 = tc0[q], c1 = tc1[q], s0 = ts0[q], s1 = ts1[q];
            const f32x4 x1a = acc[ai][0][m][0], x1b = acc[ai][0][m][1], x2a = acc[ai][1][m][0], x2b = acc[ai][1][m][1];
            const f32x4 o1a = x1a * c0 - x2a * s0, o1b = x1b * c1 - x2b * s1, o2a = x2a * c0 + x1a * s0, o2b = x2b * c1 + x1b * s1;
            if (rg == 1) { ks[0] += o1a; ks[1] += o1b; ks[2] += o2a; ks[3] += o2b; }
            bf16_t* rowp = dst + (size_t)row * 512 + col0;
            *(u32x4*)(rowp) = pack8(o1a * sc, o1b * sc); *(u32x4*)(rowp + 32) = pack8(o2a * sc, o2b * sc); }
        }
        if (rg == 1) {
#pragma unroll
            for (int q = 0; q < 4; ++q)
#pragma unroll
                for (int i = 0; i < 4; ++i) { float v = ks[q][i]; v += __shfl_xor(v, 1); v += __shfl_xor(v, 2); v += __shfl_xor(v, 4); v += __shfl_xor(v, 8); ks[q][i] = v; }
            if (fr == 0) { const int b = u.pm >> 3, blk = u.pm & 7, h = pl * 4 + wc;
                float* kp = kpart + ((((size_t)wr * 16 + b) * 8 + h) * 8 + blk) * 64 + 8 * fq;
                *(f32x4*)(kp) = ks[0]; *(f32x4*)(kp + 4) = ks[1]; *(f32x4*)(kp + 32) = ks[2]; *(f32x4*)(kp + 36) = ks[3]; }
        }
    }
};

struct EpiMerge2 {
    bf16_t* merged; const bf16_t* gates;
    static __device__ __forceinline__ float ub(unsigned w, int i) { return (float)((w >> (8 * i)) & 0xffu); }
    __device__ __forceinline__ void mid(f32x4 (&acc)[2][2][4][2], const Unit& u, int wr, int wc, int fr, int fq) const {
        const int row0 = u.pm * BM + wr * 64 + fr, col0 = u.pn * BM + wc * 64 + 16 * fq; const unsigned char* g8 = (const unsigned char*)gates;
        EPI_ROWLOOP { const int row = row0 + ai * HALF + m * 16; const unsigned char* gp = g8 + (size_t)row * 2048 + col0;
            const u32x4 w0 = *(const u32x4*)gp, w1 = *(const u32x4*)(gp + 1024);
#pragma unroll
            for (int bj = 0; bj < 2; ++bj)
#pragma unroll
                for (int i = 0; i < 4; ++i) { acc[ai][bj][m][0][i] *= ub(w0[2 * bj], i) * __builtin_amdgcn_rcpf(ub(w1[2 * bj], i)); acc[ai][bj][m][1][i] *= ub(w0[2 * bj + 1], i) * __builtin_amdgcn_rcpf(ub(w1[2 * bj + 1], i)); } }
    }
    __device__ __forceinline__ void operator()(const f32x4 (&acc)[2][2][4][2], const Unit& u, int wr, int wc, int fr, int fq) const {
        const int row0 = u.pm * BM + wr * 64 + fr, col0 = u.pn * BM + wc * 64 + 16 * fq; const unsigned char* g8 = (const unsigned char*)gates;
        EPI_ROWLOOP { const int row = row0 + ai * HALF + m * 16;
            const u32x4 w1 = *(const u32x4*)(g8 + (size_t)row * 2048 + 1024 + col0);
#pragma unroll
            for (int bj = 0; bj < 2; ++bj) { f32x4 ga, gb;
#pragma unroll
                for (int i = 0; i < 4; ++i) { ga[i] = ub(w1[2 * bj], i) * (1.0f / 255.0f); gb[i] = ub(w1[2 * bj + 1], i) * (1.0f / 255.0f); }
                *(u32x4*)(merged + (size_t)row * 1024 + col0 + 8 * bj) = pack8(acc[ai][bj][m][0] * ga, acc[ai][bj][m][1] * gb); } }
    }
};

template <int PASS> struct EpiMerge {
    bf16_t* merged; const bf16_t* gates;
    __device__ __forceinline__ void operator()(const f32x4 (&acc)[2][2][4][2], const Unit& u, int wr, int wc, int fr, int fq) const {
        const int row0 = u.pm * BM + wr * 64 + fr, col0 = u.pn * BM + wc * 32 + 8 * fq;
        EPI_ROWLOOP { const int row = row0 + ai * HALF + m * 16;
#pragma unroll
            for (int bj = 0; bj < 2; ++bj) { const int col = col0 + bj * HALF;
                f32x4 ga, gb; unpack8(*(const u32x4*)(gates + (size_t)row * 2048 + PASS * 1024 + col), ga, gb);
                f32x4 a = acc[ai][bj][m][0] * ga, b = acc[ai][bj][m][1] * gb;
                bf16_t* mp = merged + (size_t)row * 1024 + col;
                if (PASS == 1) { f32x4 pa, pb; unpack8(*(const u32x4*)mp, pa, pb); a += pa; b += pb; }
                *(u32x4*)mp = pack8(a, b); } }
    }
};

struct EpiRes {
    const float* x; bf16_t* x1b; float* ssqp; unsigned char* x1f8;
    __device__ __forceinline__ void operator()(const f32x4 (&acc)[2][2][4][2], const Unit& u, int wr, int wc, int fr, int fq) const {
        const int row0 = u.pm * BM + wr * 64 + fr, col0 = u.pn * BM + wc * 64 + 16 * fq;
#pragma unroll
        for (int ai = 0; ai < 2; ++ai) {
            f32x4 xa[4][2], xb[4][2];
#pragma unroll
            for (int m = 0; m < 4; ++m)
#pragma unroll
                for (int bj = 0; bj < 2; ++bj) { const size_t off = (size_t)(row0 + ai * HALF + m * 16) * 1024 + col0 + bj * 8; xa[m][bj] = *(const f32x4*)(x + off); xb[m][bj] = *(const f32x4*)(x + off + 4); }
#pragma unroll
            for (int m = 0; m < 4; ++m) { const int row = row0 + ai * HALF + m * 16; float ss = 0.f; u32x4 w8;
#pragma unroll
                for (int bj = 0; bj < 2; ++bj) { const size_t off = (size_t)row * 1024 + col0 + bj * 8;
                    const f32x4 a = acc[ai][bj][m][0] + xa[m][bj], b = acc[ai][bj][m][1] + xb[m][bj];
                    ss += (a[0] * a[0] + a[1] * a[1]) + (a[2] * a[2] + a[3] * a[3]) + (b[0] * b[0] + b[1] * b[1]) + (b[2] * b[2] + b[3] * b[3]);
                    *(u32x4*)(x1b + off) = pack8(a, b); const u32x2 p = pack8_fp8(a, b); w8[2 * bj] = p.x; w8[2 * bj + 1] = p.y; }
                *(u32x4*)(x1f8 + (size_t)row * 1024 + col0) = w8;
                ss += __shfl_xor(ss, 16); ss += __shfl_xor(ss, 32);
                if (fq == 0) ssqp[(size_t)row * 16 + u.pn * 4 + wc] = ss; }
        }
    }
};

struct EpiNull {
    float* sink;
    __device__ __forceinline__ void operator()(const f32x4 (&acc)[2][2][4][2], const Unit& u, int wr, int wc, int fr, int fq) const {
        f32x4 s = {0.f, 0.f, 0.f, 0.f};
        EPI_ROWLOOP {
#pragma unroll
            for (int bj = 0; bj < 2; ++bj) s += acc[ai][bj][m][0] + acc[ai][bj][m][1]; }
        if (s[0] + s[1] + s[2] + s[3] == 12345.678f) sink[u.pm] = s[0];
    }
};

struct EpiAct {
    unsigned char* act; const unsigned* list;
    __device__ __forceinline__ void prefetch(const Unit& u, int wr, int fr, unsigned (&ea)[8], float (&ef)[8]) const {
        EPI_ROWLOOP { const int idx = u.ti * 256 + ai * HALF + wr * 64 + m * 16 + fr; const bool ok = idx < u.cnt;
            const unsigned* rp = list + ((size_t)u.e * LISTCAP + (ok ? idx : 0)) * 4; const unsigned a = rp[0]; ea[ai * 4 + m] = ok ? a : 0xffffffffu; ef[ai * 4 + m] = __builtin_bit_cast(float, rp[2]); }
    }
    __device__ __forceinline__ void operator()(const f32x4 (&acc)[2][2][4][2], const Unit& u, int wr, int wc, int fr, int fq, const unsigned (&ea)[8], const float (&rsv)[8]) const {
        const int pnl = u.pn & 3;
#pragma unroll
        for (int ai = 0; ai < 2; ++ai)
#pragma unroll
            for (int mp = 0; mp < 4; mp += 2) {
                u32x2 p[2];
#pragma unroll
                for (int q = 0; q < 2; ++q) { const int m = mp + q; const float rs = rsv[ai * 4 + m]; f32x4 o[2];
#pragma unroll
                    for (int n = 0; n < 2; ++n) { const f32x4 gq = acc[ai][0][m][n] * rs, uq = acc[ai][1][m][n] * rs;
#pragma unroll
                        for (int i = 0; i < 4; ++i) o[n][i] = gq[i] * sigmoidf_(gq[i]) * uq[i]; }
                    p[q] = pack8_fp8(o[0], o[1]); }
                const auto lo = __builtin_amdgcn_permlane16_swap(p[0].x, p[1].x, false, false), hi = __builtin_amdgcn_permlane16_swap(p[0].y, p[1].y, false, false);
                const unsigned a = (fq & 1) ? ea[ai * 4 + mp + 1] : ea[ai * 4 + mp];
                if (a != 0xffffffffu) *(u32x4*)(act + (size_t)a * 512 + pnl * 128 + wc * 32 + 16 * (fq >> 1)) = (u32x4){(unsigned)lo[0], (unsigned)hi[0], (unsigned)lo[1], (unsigned)hi[1]}; }
    }
};

struct EpiDown {
    unsigned char* yc; const unsigned* list;
    __device__ __forceinline__ void prefetch(const Unit& u, int wr, int fr, unsigned (&ea)[8], float (&ef)[8]) const {
        EPI_ROWLOOP { const int idx = u.ti * 256 + ai * HALF + wr * 64 + m * 16 + fr; const bool ok = idx < u.cnt;
            const unsigned* rp = list + ((size_t)u.e * LISTCAP + (ok ? idx : 0)) * 4; const unsigned a = rp[0]; ea[ai * 4 + m] = ok ? a : 0xffffffffu; ef[ai * 4 + m] = __builtin_bit_cast(float, rp[1]) * 16.0f; }
    }
    __device__ __forceinline__ void operator()(const f32x4 (&acc)[2][2][4][2], const Unit& u, int wr, int wc, int fr, int fq, const unsigned (&ea)[8], const float (&wv)[8]) const {
        const int pnl = u.pn & 3, col0 = pnl * 256 + wc * 64 + 16 * fq;
        EPI_ROWLOOP { const unsigned a = ea[ai * 4 + m];
            if (a != 0xffffffffu) { const float w = wv[ai * 4 + m];
                const u32x2 p0 = pack8_fp8(acc[ai][0][m][0] * w, acc[ai][0][m][1] * w), p1 = pack8_fp8(acc[ai][1][m][0] * w, acc[ai][1][m][1] * w);
                *(u32x4*)(yc + (size_t)a * 1024 + col0) = (u32x4){p0.x, p0.y, p1.x, p1.y}; } }
    }
};

struct MoeOrder {
    const PG8_LAS int* tpre;
    const PG8_LAS int* cnts;
    const unsigned* list; int G, c, total, shift; unsigned rowbytes;
    __device__ __forceinline__ bool next(int i, Unit& u) const {
        const int L = i * G + c; if (L >= total) return false;
        const int tt = L >> 2; int e = 0;
        for (int j = 1; j < NEXP; ++j) e += (tt >= tpre[j]) ? 1 : 0;
        e = __builtin_amdgcn_readfirstlane(e);
        u.e = e; u.ti = __builtin_amdgcn_readfirstlane(tt - tpre[e]); u.cnt = __builtin_amdgcn_readfirstlane(cnts[e]); u.pn = e * 4 + (L & 3); u.pm = tt; return true;
    }
    __device__ __forceinline__ unsigned arow(const Unit& u, int tr) const { int idx = u.ti * 256 + tr; idx = idx < u.cnt ? idx : u.cnt - 1; const unsigned a = list[((size_t)u.e * LISTCAP + idx) * 4]; return (a >> shift) * rowbytes; }
    __device__ __forceinline__ void a_ready(const Unit&) const {}
    __device__ __forceinline__ void done(const Unit&) const {}
};
#undef EPI_ROWLOOP
}

namespace attn_body {
using bf16=__hip_bfloat16;
using bf16x8=__attribute__((ext_vector_type(8)))short;
using s16x4=__attribute__((ext_vector_type(4)))short;
using f32x16=__attribute__((ext_vector_type(16)))float;
using u32x4=__attribute__((ext_vector_type(4)))unsigned;
using f32x4=__attribute__((ext_vector_type(4)))float;
constexpr int SEQ=2048,D=64,PQ=512;
constexpr int NW=8,QBLK=32,QB=QBLK*NW,KVBLK=64,NQB=SEQ/QB;
constexpr int ATTN_UNIT_ROWS=QB;
__device__ __forceinline__ int crow(int r,int hi){return (r&3)+8*(r>>2)+4*hi;}
#define SBAR() __builtin_amdgcn_sched_barrier(0)
__device__ __forceinline__ void cmask(f32x16&p0,f32x16&p1,int jb,int qrel,int hi){
  const float NEG=-INFINITY; int kb=64*jb+4*hi;
  #pragma unroll
  for(int r=0;r<16;++r){int kv=kb+(r&3)+8*(r>>2); if(kv>qrel)p0[r]=NEG; if(kv+32>qrel)p1[r]=NEG;}
}

constexpr int NSLOT=3, SLOTB=8192;
constexpr int LDS_K=0, LDS_V=NSLOT*SLOTB, LDS_WS=2*NSLOT*SLOTB, LDS_OST=LDS_WS+NW*64*4, LDS_BYTES=LDS_OST+NW*4096;
constexpr float C2=0.125f*1.4426950408889634f;
__device__ __forceinline__ void glds16(const void*gsrc,unsigned lds_dst){unsigned keep;
  asm volatile("s_mov_b32 %0, m0\n\ts_mov_b32 m0, %2\n\ts_nop 0\n\tglobal_load_lds_dwordx4 %1, off\n\ts_mov_b32 m0, %0":"=&s"(keep):"v"(gsrc),"s"(lds_dst):"memory");}
__device__ __forceinline__ float max3f(float a,float b,float c){float r;asm("v_max3_f32 %0, %1, %2, %3":"=v"(r):"v"(a),"v"(b),"v"(c));return r;}
__device__ __forceinline__ float max2f(float a,float b){float r;asm("v_max_f32_e32 %0, %1, %2":"=v"(r):"v"(a),"v"(b));return r;}
__device__ __forceinline__ float fadd_s(float a,float b){float r;asm("v_add_f32_e32 %0, %1, %2":"=v"(r):"v"(a),"v"(b));return r;}
__device__ __forceinline__ float fsub_s(float a,float b){float r;asm("v_sub_f32_e32 %0, %1, %2":"=v"(r):"v"(a),"v"(b));return r;}
typedef float f32x2_t __attribute__((ext_vector_type(2))); typedef __bf16 bf16x2_t __attribute__((ext_vector_type(2)));
__device__ __forceinline__ unsigned cvtpk_s(float lo,float hi){f32x2_t v={lo,hi};bf16x2_t b=__builtin_convertvector(v,bf16x2_t);return __builtin_bit_cast(unsigned,b);}
#define WAIT_BAR(N) asm volatile("s_waitcnt vmcnt(" #N ") lgkmcnt(0)\n\ts_barrier":::"memory")

__device__ __forceinline__ void qkt(f32x16&p0,f32x16&p1,const char*Kslot,const bf16x8*qr,const f32x16&negm,int r32,int hi){
  const char*kb=Kslot+hi*1024+r32*16;
  #pragma unroll
  for(int d0=0;d0<4;++d0){
    const bf16x8 b0=*reinterpret_cast<const bf16x8*>(kb+d0*2048);
    const bf16x8 b1=*reinterpret_cast<const bf16x8*>(kb+d0*2048+512);
    if(d0==0){p0=__builtin_amdgcn_mfma_f32_32x32x16_bf16(b0,qr[0],negm,0,0,0);p1=__builtin_amdgcn_mfma_f32_32x32x16_bf16(b1,qr[0],negm,0,0,0);}
    else{p0=__builtin_amdgcn_mfma_f32_32x32x16_bf16(b0,qr[d0],p0,0,0,0);p1=__builtin_amdgcn_mfma_f32_32x32x16_bf16(b1,qr[d0],p1,0,0,0);}}
}
typedef __attribute__((address_space(3))) const char* lds_cptr;
typedef short v4i16_t __attribute__((ext_vector_type(4)));
__device__ __forceinline__ void kload8(bf16x8*kf,lds_cptr kp){
  kf[0]=*(const __attribute__((address_space(3))) bf16x8*)(kp);      kf[1]=*(const __attribute__((address_space(3))) bf16x8*)(kp+512);
  kf[2]=*(const __attribute__((address_space(3))) bf16x8*)(kp+2048); kf[3]=*(const __attribute__((address_space(3))) bf16x8*)(kp+2560);
  kf[4]=*(const __attribute__((address_space(3))) bf16x8*)(kp+4096); kf[5]=*(const __attribute__((address_space(3))) bf16x8*)(kp+4608);
  kf[6]=*(const __attribute__((address_space(3))) bf16x8*)(kp+6144); kf[7]=*(const __attribute__((address_space(3))) bf16x8*)(kp+6656);
}
__device__ __forceinline__ void kload2(bf16x8*kf,lds_cptr kp,int j){ kf[2*j]=*(const __attribute__((address_space(3))) bf16x8*)(kp+j*2048); kf[2*j+1]=*(const __attribute__((address_space(3))) bf16x8*)(kp+j*2048+512); }
__device__ __forceinline__ s16x4 vtr(lds_cptr p){ return __builtin_bit_cast(s16x4,__builtin_amdgcn_ds_read_tr16_b64_v4i16((__attribute__((address_space(3))) v4i16_t*)p)); }
__device__ __forceinline__ float rowmax(const f32x16&p0,const f32x16&p1){
  float a=max3f(p0[0],p0[1],p1[0]),b=max3f(p0[2],p0[3],p1[1]);a=max3f(a,p1[2],p1[3]);
  #pragma unroll
  for(int r=4;r<16;r+=4){a=max3f(a,p0[r],p0[r+1]);b=max3f(b,p0[r+2],p0[r+3]);a=max3f(a,p1[r],p1[r+1]);b=max3f(b,p1[r+2],p1[r+3]);}
  const float m=max2f(a,b);
  auto rr=__builtin_amdgcn_permlane32_swap(__float_as_uint(m),__float_as_uint(m),false,false);
  return max2f(__uint_as_float(rr[0]),__uint_as_float(rr[1]));
}
__device__ __forceinline__ void pv(f32x16*o,int vb,bf16x8 pa0,bf16x8 pa1,bf16x8 pa2,bf16x8 pa3){
  #pragma unroll
  for(int d0=0;d0<2;++d0){s16x4 lo[4],hi[4];
    #pragma unroll
    for(int ks=0;ks<4;++ks){
      asm volatile("ds_read_b64_tr_b16 %0,%1 offset:%c2":"=&v"(lo[ks]):"v"(vb),"i"(d0*4096+ks*1024):"memory");
      asm volatile("ds_read_b64_tr_b16 %0,%1 offset:%c2":"=&v"(hi[ks]):"v"(vb),"i"(d0*4096+ks*1024+512):"memory");}
    asm volatile("s_waitcnt lgkmcnt(0)":::"memory");SBAR();
    #define PK(k) (bf16x8){lo[k][0],lo[k][1],lo[k][2],lo[k][3],hi[k][0],hi[k][1],hi[k][2],hi[k][3]}
    o[d0]=__builtin_amdgcn_mfma_f32_32x32x16_bf16(pa0,PK(0),o[d0],0,0,0);
    o[d0]=__builtin_amdgcn_mfma_f32_32x32x16_bf16(pa1,PK(1),o[d0],0,0,0);
    o[d0]=__builtin_amdgcn_mfma_f32_32x32x16_bf16(pa2,PK(2),o[d0],0,0,0);
    o[d0]=__builtin_amdgcn_mfma_f32_32x32x16_bf16(pa3,PK(3),o[d0],0,0,0);
    #undef PK
  }
}

#ifndef ATTN_STORE16
#define ATTN_STORE16(p,v) (*(u32x4*)(p)=(v))
#endif
template<int THRL,bool MOBA,int PO,bool NOMASK=false> __device__ __forceinline__ int attn_unit(int qb,const bf16*Qb,const bf16*__restrict__ Kh,const bf16*__restrict__ Vh,bf16*Ob,const float*kmA,const float*kmB,char*shm,int s0,bool pre,const bf16*nKh,const bf16*nVh){
  int tid_=threadIdx.x; asm volatile("":"+v"(tid_));
  const int tid=tid_,lane=tid&63,r32=lane&31,hi=lane>>5; const int wid=__builtin_amdgcn_readfirstlane(tid>>6);
  const int q0=qb*QB;
  const bf16*Qw=Qb+(long)(q0+wid*QBLK)*PQ;
  const unsigned lds0=(unsigned)(uintptr_t)shm;
  float*wsf=(float*)(shm+LDS_WS)+wid*64;
  const bf16*ksrc=Kh+(long)lane*PQ+wid*8;
  const bf16*vsrc=Vh+(long)(16*(wid&3)+(lane>>2))*PQ+(wid>>2)*32+(lane&3)*8;
  const unsigned kdst=lds0+LDS_K+wid*1024, vdst=lds0+LDS_V+wid*1024;
  #define DMA_K(t,slot) glds16(ksrc+(long)(t)*KVBLK*PQ,(unsigned)__builtin_amdgcn_readfirstlane(kdst+(slot)))
  #define DMA_V(t,slot) glds16(vsrc+(long)(t)*KVBLK*PQ,(unsigned)__builtin_amdgcn_readfirstlane(vdst+(slot)))
  const int vb0=(int)(lds0+LDS_V)+((lane>>4)&1)*32+(lane&3)*8+(4*hi+((lane&15)>>2))*64;
  const char*Kbase=shm+LDS_K; bf16x8 kf[8];
  const lds_cptr shm3=(lds_cptr)shm; const lds_cptr kp0=shm3+LDS_K+hi*1024+r32*16; const lds_cptr vp0=shm3+LDS_V+((lane>>4)&1)*32+(lane&3)*8+(4*hi+((lane&15)>>2))*64;
  const int NT=(q0+QB)/KVBLK;
  const int S0=s0,S1=(S0==(NSLOT-1)*SLOTB)?0:S0+SLOTB,S2=(S1==(NSLOT-1)*SLOTB)?0:S1+SLOTB;
  if(!pre){DMA_K(0,S0);DMA_V(0,S0);DMA_K(1,S1);}
  bf16x8 qr[4];
  #pragma unroll
  for(int d0=0;d0<4;++d0)qr[d0]=*reinterpret_cast<const bf16x8*>(&Qw[(long)r32*PQ+d0*16+hi*8]);
  unsigned selmask=0xFFu;
  if constexpr(MOBA){
    f32x16 gt=f32x16{};
    #pragma unroll
    for(int d0=0;d0<4;++d0){ const bf16x8 kfm=*(const __attribute__((address_space(3))) bf16x8*)((lds_cptr)kmA+d0*1024+lane*16);
      gt=__builtin_amdgcn_mfma_f32_32x32x16_bf16(kfm,qr[d0],gt,0,0,0); }
    float gv[8];
    #pragma unroll
    for(int i=0;i<4;++i){ auto rr=__builtin_amdgcn_permlane32_swap(__float_as_uint(gt[i]),__float_as_uint(gt[i]),false,false); gv[i]=__uint_as_float(rr[0]); gv[4+i]=__uint_as_float(rr[1]); }
    unsigned sel=0u;
    #pragma unroll
    for(int k=0;k<3;++k){ float best=-INFINITY; int bi=8;
      #pragma unroll
      for(int j=0;j<8;++j){ const bool ok=(j<qb)&&(((sel>>j)&1u)==0u)&&(gv[j]>best); best=ok?gv[j]:best; bi=ok?j:bi; }
      sel|=(bi<8)?(1u<<bi):0u; }
    selmask=sel|(1u<<qb);
  }
  #define MMASK(P0,P1,t) do{ if constexpr(MOBA&&!NOMASK){ const bool keep_=((selmask>>((t)>>2))&1u)!=0u; _Pragma("unroll") for(int r=0;r<16;++r){P0[r]=keep_?P0[r]:-INFINITY;P1[r]=keep_?P1[r]:-INFINITY;} } }while(0)
  float mhat=0.f,l_reg=0.f;f32x16 o[2];o[0]=f32x16{};o[1]=f32x16{};f32x16 negm=f32x16{};asm volatile("":"+v"(negm)); f32x16 negk=negm;
  const int qrel=wid*QBLK+r32;
  #define CMASK(P0,P1,t) do{int jb_=(t)-(NT-4); if(jb_>=0)cmask(P0,P1,jb_,qrel,hi);}while(0)
  bool resc=false;
  #define START(P0,P1) do{ const float rm=rowmax(P0,P1); resc=false; \
    { const float dl=(rm==-INFINITY)?0.f:rm; mhat=fadd_s(mhat,dl); \
      _Pragma("unroll") for(int r=0;r<16;++r){P0[r]=fsub_s(P0[r],dl);P1[r]=fsub_s(P1[r],dl);} \
      _Pragma("unroll") for(int r=0;r<16;++r)negm[r]=-mhat; asm volatile("":"+v"(negm)); } \
    _Pragma("unroll") for(int r=0;r<16;++r)P0[r]=__builtin_amdgcn_exp2f(P0[r]); }while(0)
  #define RESC() do{ if(resc){ asm volatile("s_waitcnt lgkmcnt(0)":::"memory"); \
      _Pragma("unroll") for(int d_=0;d_<2;++d_) _Pragma("unroll") for(int r=0;r<16;++r)o[d_][r]*=wsf[crow(r,hi)]; } }while(0)
  f32x16 pA0,pA1,pB0,pB1;
  int sl_prev=S0,sl_cur=S0,sl_next=S1;
  #define ROT() do{sl_prev=sl_cur;sl_cur=sl_next;sl_next=(sl_next==(NSLOT-1)*SLOTB)?0:sl_next+SLOTB;}while(0)
  DMA_K(2,S2);
  WAIT_BAR(3);
  qkt(pA0,pA1,Kbase+S0,qr,negm,r32,hi);asm volatile("s_nop 15\n\ts_nop 7":"+v"(pA0),"+v"(pA1));MMASK(pA0,pA1,0);CMASK(pA0,pA1,0);
  START(pA0,pA1);
  { const bool kn_=!MOBA||(((selmask>>0)&1u)!=0u); const float nv_=kn_?-mhat:-INFINITY; _Pragma("unroll") for(int r=0;r<16;++r)negk[r]=nv_; asm volatile("":"+v"(negk)); }
  _Pragma("unroll") for(int r=0;r<16;++r)pA1[r]=__builtin_amdgcn_exp2f(pA1[r]);
  WAIT_BAR(0);
  DMA_K(3,S0);DMA_V(1,S1);
  ROT();
  kload8(kf,kp0+sl_cur);
  WAIT_BAR(2);
  s16x4 vlo[4],vhi[4]; u32x4 pw0,pw1,pw2,pw3;
  #define PKW(P,B) cvtpk_s(P[B],P[B+1])
  #define PAF(k) __builtin_bit_cast(bf16x8,pw##k)
  #define VFR(i) (bf16x8){vlo[i][0],vlo[i][1],vlo[i][2],vlo[i][3],vhi[i][0],vhi[i][1],vhi[i][2],vhi[i][3]}
  #define PIN(x) asm volatile("":"+v"(x))
  #define MX3(a,b,c) __builtin_fmaxf(__builtin_fmaxf((a),(b)),(c))
  #define GAPA(MF,A0,A1,A2,A3,W0,W1,PW) do{ MF; sacc+=A0; sacc+=A1; sacc+=A2; sacc+=A3; PIN(sacc); W0; W1; PIN(PW); SBAR(); }while(0)
  #define EX(v) __builtin_amdgcn_exp2f(v)
  #define GAPB(MF,X,B) do{ MF; X[B]=EX(X[B]); X[B+1]=EX(X[B+1]); X[B+2]=EX(X[B+2]); X[B+3]=EX(X[B+3]); PIN(X); SBAR(); }while(0)
  #define VRD(i) do{ vlo[i]=vtr(vp_+(((i)>>2)*4096+((i)&3)*1024)); vhi[i]=vtr(vp_+(((i)>>2)*4096+((i)&3)*1024+512)); }while(0)
  #define VRDX(sl,f) do{ vlo[sl]=vtr(vp_+(((f)>>2)*4096+((f)&3)*1024)); vhi[sl]=vtr(vp_+(((f)>>2)*4096+((f)&3)*1024+512)); SBAR(); }while(0)
  #define KRD(G,j) do{ if(G){ kload2(kf,kp0+sl_next,j); SBAR(); } }while(0)
  #define STEP(C0,C1,P0,P1,t,GK,GV,GL) do{ SBAR(); \
    const lds_cptr vp_=vp0+sl_prev; \
    VRD(0); SBAR(); float sacc=(P0[0]+P0[1]); \
    GAPA(C0=__builtin_amdgcn_mfma_f32_32x32x16_bf16(kf[0],qr[0],negk,0,0,0), P0[2],P0[3],P0[4],P0[5],     pw0[0]=PKW(P0,0), pw0[1]=PKW(P0,2), pw0); \
    GAPA(C1=__builtin_amdgcn_mfma_f32_32x32x16_bf16(kf[1],qr[0],negk,0,0,0), P0[6],P0[7],P0[8],P0[9],     pw0[2]=PKW(P0,4), pw0[3]=PKW(P0,6), pw0); \
    VRD(1); SBAR(); GAPA(C0=__builtin_amdgcn_mfma_f32_32x32x16_bf16(kf[2],qr[1],C0,0,0,0),   P0[10],P0[11],P0[12],P0[13], pw1[0]=PKW(P0,8), pw1[1]=PKW(P0,10), pw1); \
    GAPA(C1=__builtin_amdgcn_mfma_f32_32x32x16_bf16(kf[3],qr[1],C1,0,0,0),   P0[14],P0[15],P1[0],P1[1],   pw1[2]=PKW(P0,12),pw1[3]=PKW(P0,14), pw1); \
    VRD(2); SBAR(); GAPA(C0=__builtin_amdgcn_mfma_f32_32x32x16_bf16(kf[4],qr[2],C0,0,0,0),   P1[2],P1[3],P1[4],P1[5],     pw2[0]=PKW(P1,0), pw2[1]=PKW(P1,2), pw2); \
    GAPA(C1=__builtin_amdgcn_mfma_f32_32x32x16_bf16(kf[5],qr[2],C1,0,0,0),   P1[6],P1[7],P1[8],P1[9],     pw2[2]=PKW(P1,4), pw2[3]=PKW(P1,6), pw2); \
    VRD(3); SBAR(); GAPA(C0=__builtin_amdgcn_mfma_f32_32x32x16_bf16(kf[6],qr[3],C0,0,0,0),   P1[10],P1[11],P1[12],P1[13], pw3[0]=PKW(P1,8), pw3[1]=PKW(P1,10), pw3); \
    GAPA(C1=__builtin_amdgcn_mfma_f32_32x32x16_bf16(kf[7],qr[3],C1,0,0,0),   P1[14],P1[15],0.f,0.f,       pw3[2]=PKW(P1,12),pw3[3]=PKW(P1,14), pw3); \
    l_reg+=sacc; \
    if(GK){DMA_K((t)+3,sl_cur);} if(GV){DMA_V((t)+1,sl_next);} \
    CMASK(C0,C1,t); \
    { float a=MX3(C0[0],C0[1],C1[0]),b=MX3(C0[2],C0[3],C1[1]); a=MX3(a,C1[2],C1[3]); \
      _Pragma("unroll") for(int r=4;r<16;r+=4){a=MX3(a,C0[r],C0[r+1]);b=MX3(b,C0[r+2],C0[r+3]);a=MX3(a,C1[r],C1[r+1]);b=MX3(b,C1[r+2],C1[r+3]);} \
      float rm=__builtin_fmaxf(a,b); { auto rr=__builtin_amdgcn_permlane32_swap(__float_as_uint(rm),__float_as_uint(rm),false,false); rm=__builtin_fmaxf(__uint_as_float(rr[0]),__uint_as_float(rr[1])); } \
      resc=false; \
      if(__builtin_expect(__any(rm>(float)THRL),0)){ const float dl=__builtin_fmaxf(rm,0.f); mhat+=dl; \
        _Pragma("unroll") for(int r=0;r<16;++r){C0[r]-=dl;C1[r]-=dl;} \
        _Pragma("unroll") for(int r=0;r<16;++r)negm[r]=-mhat; asm volatile("":"+v"(negm)); \
        const float f=__builtin_amdgcn_exp2f(-dl); l_reg*=f; if(hi==0)wsf[r32]=f; resc=true; } } \
    SBAR(); \
    GAPB(o[0]=__builtin_amdgcn_mfma_f32_32x32x16_bf16(PAF(0),VFR(0),o[0],0,0,0), C0,0); VRDX(0,4); \
    GAPB(o[0]=__builtin_amdgcn_mfma_f32_32x32x16_bf16(PAF(1),VFR(1),o[0],0,0,0), C0,4); VRDX(1,5); \
    KRD(GL,0); GAPB(o[0]=__builtin_amdgcn_mfma_f32_32x32x16_bf16(PAF(2),VFR(2),o[0],0,0,0), C0,8); VRDX(2,6); \
    KRD(GL,1); GAPB(o[0]=__builtin_amdgcn_mfma_f32_32x32x16_bf16(PAF(3),VFR(3),o[0],0,0,0), C0,12); VRDX(3,7); \
    KRD(GL,2); GAPB(o[1]=__builtin_amdgcn_mfma_f32_32x32x16_bf16(PAF(0),VFR(0),o[1],0,0,0), C1,0); \
    KRD(GL,3); GAPB(o[1]=__builtin_amdgcn_mfma_f32_32x32x16_bf16(PAF(1),VFR(1),o[1],0,0,0), C1,4); \
    GAPB(o[1]=__builtin_amdgcn_mfma_f32_32x32x16_bf16(PAF(2),VFR(2),o[1],0,0,0), C1,8); \
    GAPB(o[1]=__builtin_amdgcn_mfma_f32_32x32x16_bf16(PAF(3),VFR(3),o[1],0,0,0), C1,12); \
    { if((MOBA&&(((t)+1)&3)==0)||resc){ const bool kn_=!MOBA||((selmask>>(((t)+1)>>2))&1u)!=0u; const float nv_=kn_?-mhat:-INFINITY; _Pragma("unroll") for(int r=0;r<16;++r)negk[r]=nv_; asm volatile("":"+v"(negk)); } } \
    }while(0)
  int t=1;
  #undef CMASK
  #define CMASK(P0,P1,t) do{}while(0)
  for(;t+5<NT;t+=2){
    STEP(pB0,pB1,pA0,pA1,t,true,true,true);     WAIT_BAR(2); RESC(); ROT();
    STEP(pA0,pA1,pB0,pB1,t+1,true,true,true);   WAIT_BAR(2); RESC(); ROT();
  }
  #undef CMASK
  #define CMASK(P0,P1,t) do{int jb_=(t)-(NT-4); if(jb_>=0)cmask(P0,P1,jb_,qrel,hi);}while(0)
  #define ENDW(tt) do{ if((tt)+3<NT){WAIT_BAR(2);} else if((tt)+2<NT){WAIT_BAR(1);} else {WAIT_BAR(0);} }while(0)
  for(;t+1<NT;t+=2){
    STEP(pB0,pB1,pA0,pA1,t,(t+3<NT),(t+1<NT),(t+1<NT));       ENDW(t);   RESC(); ROT();
    STEP(pA0,pA1,pB0,pB1,t+1,(t+4<NT),(t+2<NT),(t+2<NT));     ENDW(t+1); RESC(); ROT();
  }
  STEP(pB0,pB1,pA0,pA1,NT-1,false,false,false); RESC();
  const int N0=(sl_cur==(NSLOT-1)*SLOTB)?0:sl_cur+SLOTB;
  if(nKh){ const int N1=(N0==(NSLOT-1)*SLOTB)?0:N0+SLOTB; const bf16*nks=nKh+(long)lane*PQ+wid*8; const bf16*nvs=nVh+(long)(16*(wid&3)+(lane>>2))*PQ+(wid>>2)*32+(lane&3)*8;
    glds16(nks,(unsigned)__builtin_amdgcn_readfirstlane(kdst+N0)); glds16(nvs,(unsigned)__builtin_amdgcn_readfirstlane(vdst+N0)); glds16(nks+(long)KVBLK*PQ,(unsigned)__builtin_amdgcn_readfirstlane(kdst+N1)); }
  if(wid>=6)
  { float sacc=pB0[0]+pB0[1]; _Pragma("unroll") for(int r=2;r<16;++r)sacc+=pB0[r]; _Pragma("unroll") for(int r=0;r<16;++r)sacc+=pB1[r]; l_reg+=sacc;
    pw0=(u32x4){PKW(pB0,0),PKW(pB0,2),PKW(pB0,4),PKW(pB0,6)};pw1=(u32x4){PKW(pB0,8),PKW(pB0,10),PKW(pB0,12),PKW(pB0,14)};pw2=(u32x4){PKW(pB1,0),PKW(pB1,2),PKW(pB1,4),PKW(pB1,6)};pw3=(u32x4){PKW(pB1,8),PKW(pB1,10),PKW(pB1,12),PKW(pB1,14)};
    SBAR(); pv(o,vb0+sl_cur,PAF(0),PAF(1),PAF(2),PAF(3)); }
  #undef PKW
  #undef PAF
  #undef VFR
  #undef PIN
  #undef MX3
  #undef GAPA
  #undef GAPB
  #undef EX
  #undef VRD
  #undef VRDX
  #undef KRD
  #undef STEP
  #undef ENDW
  {auto rr=__builtin_amdgcn_permlane32_swap(__float_as_uint(l_reg),__float_as_uint(l_reg),false,false);l_reg=__uint_as_float(rr[0])+__uint_as_float(rr[1]);}
  if(hi==0)wsf[32+r32]=l_reg;asm volatile("s_waitcnt lgkmcnt(0)":::"memory");
  float rli[16];
  #pragma unroll
  for(int r=0;r<16;++r)rli[r]=__builtin_amdgcn_rcpf(wsf[32+crow(r,hi)]);
  bf16*Ow=Ob+(long)(q0+wid*QBLK)*PO;
  { bf16*stg=(bf16*)(shm+LDS_OST)+wid*2048;
    #pragma unroll
    for(int r=0;r<16;++r){const int orow=crow(r,hi);
      #pragma unroll
      for(int d0=0;d0<2;++d0)stg[orow*64+d0*32+r32]=__float2bfloat16(o[d0][r]*rli[r]);}
    asm volatile("s_waitcnt lgkmcnt(0)":::"memory");
    #pragma unroll
    for(int i=0;i<4;++i){const int row=i*8+(lane>>3),ch=lane&7; const u32x4 v=*(const u32x4*)(stg+row*64+ch*8); ATTN_STORE16(Ow+(long)row*PO+ch*8,v);} }
  asm volatile("s_waitcnt lgkmcnt(0)\n\ts_barrier":::"memory");
  #undef DMA_K
  #undef DMA_V
  #undef CMASK
  #undef MMASK
  #undef START
  #undef RESC
  #undef ROT
  return N0;
}
template<int THRL,int PO> __device__ __forceinline__ int attn_unit128(int qb,const bf16*Qb,const bf16*__restrict__ Kh,const bf16*__restrict__ Vh,bf16*Ob,char*shm,int s0,bool pre,const bf16*nKh,const bf16*nVh){
  constexpr bool MOBA=false; constexpr int LDS_V=NSLOT*SLOTB, LDS_WS=LDS_V+NSLOT*2*SLOTB, LDS_OST=LDS_WS+NW*64*4;
  const float*kmA=nullptr,*kmB=nullptr;
  int tid_=threadIdx.x; asm volatile("":"+v"(tid_));
  const int tid=tid_,lane=tid&63,r32=lane&31,hi=lane>>5; const int wid=__builtin_amdgcn_readfirstlane(tid>>6);
  const int q0=qb*QB;
  const bf16*Qw=Qb+(long)(q0+wid*QBLK)*PQ;
  const unsigned lds0=(unsigned)(uintptr_t)shm;
  float*wsf=(float*)(shm+LDS_WS)+wid*64;
  const bf16*ksrc=Kh+(long)lane*PQ+wid*8;
  const bf16*vsrc=Vh+(long)(16*(wid&3)+(lane>>2))*PQ+(wid>>2)*32+(lane&3)*8;
  const unsigned kdst=lds0+LDS_K+wid*1024, vdst=lds0+LDS_V+wid*1024;
  #define DMA_K(t,slot) glds16(ksrc+(long)(t)*KVBLK*PQ,(unsigned)__builtin_amdgcn_readfirstlane(kdst+(slot)))
  #define DMA_V(t,slot) do{ glds16(vsrc+(long)(t)*KVBLK*PQ,(unsigned)__builtin_amdgcn_readfirstlane(vdst+2*(slot))); glds16(vsrc+64+(long)(t)*KVBLK*PQ,(unsigned)__builtin_amdgcn_readfirstlane(vdst+2*(slot)+8192)); }while(0)
  const int vb0=(int)(lds0+LDS_V)+((lane>>4)&1)*32+(lane&3)*8+(4*hi+((lane&15)>>2))*64;
  const char*Kbase=shm+LDS_K; bf16x8 kf[8];
  const lds_cptr shm3=(lds_cptr)shm; const lds_cptr kp0=shm3+LDS_K+hi*1024+r32*16; const lds_cptr vp0=shm3+LDS_V+((lane>>4)&1)*32+(lane&3)*8+(4*hi+((lane&15)>>2))*64;
  const int NT=(q0+QB)/KVBLK;
  const int S0=s0,S1=(S0==(NSLOT-1)*SLOTB)?0:S0+SLOTB,S2=(S1==(NSLOT-1)*SLOTB)?0:S1+SLOTB;
  if(!pre){DMA_K(0,S0);DMA_V(0,S0);DMA_K(1,S1);}
  bf16x8 qr[4];
  #pragma unroll
  for(int d0=0;d0<4;++d0)qr[d0]=*reinterpret_cast<const bf16x8*>(&Qw[(long)r32*PQ+d0*16+hi*8]);
  unsigned selmask=0xFFu;
  if constexpr(MOBA){
    f32x16 gt=f32x16{}; const int jr=r32&7; const float kz=(r32<8)?(1.f/256.f):0.f;
    #pragma unroll
    for(int d0=0;d0<4;++d0){ const float*p0=kmA+jr*64+d0*16+hi*8; const float*p1=kmB+jr*64+d0*16+hi*8;
      const f32x4 a0=*(const f32x4*)p0,a1=*(const f32x4*)(p0+4),b0=*(const f32x4*)p1,b1=*(const f32x4*)(p1+4);
      u32x4 w; w[0]=cvtpk_s((a0[0]+b0[0])*kz,(a0[1]+b0[1])*kz); w[1]=cvtpk_s((a0[2]+b0[2])*kz,(a0[3]+b0[3])*kz); w[2]=cvtpk_s((a1[0]+b1[0])*kz,(a1[1]+b1[1])*kz); w[3]=cvtpk_s((a1[2]+b1[2])*kz,(a1[3]+b1[3])*kz);
      gt=__builtin_amdgcn_mfma_f32_32x32x16_bf16(__builtin_bit_cast(bf16x8,w),qr[d0],gt,0,0,0); }
    float gv[8];
    #pragma unroll
    for(int i=0;i<4;++i){ auto rr=__builtin_amdgcn_permlane32_swap(__float_as_uint(gt[i]),__float_as_uint(gt[i]),false,false); gv[i]=__uint_as_float(rr[0]); gv[4+i]=__uint_as_float(rr[1]); }
    unsigned sel=0u;
    #pragma unroll
    for(int k=0;k<3;++k){ float best=-INFINITY; int bi=8;
      #pragma unroll
      for(int j=0;j<8;++j){ const bool ok=(j<qb)&&(((sel>>j)&1u)==0u)&&(gv[j]>best); best=ok?gv[j]:best; bi=ok?j:bi; }
      sel|=(bi<8)?(1u<<bi):0u; }
    selmask=sel|(1u<<qb);
  }
  #define MMASK(P0,P1,t) do{ if constexpr(MOBA){ const bool keep_=((selmask>>((t)>>2))&1u)!=0u; _Pragma("unroll") for(int r=0;r<16;++r){P0[r]=keep_?P0[r]:-INFINITY;P1[r]=keep_?P1[r]:-INFINITY;} } }while(0)
  float zz=0.f; asm volatile("":"+v"(zz));
  float mhat=0.f,l_reg=0.f;f32x16 o[4],negm; _Pragma("unroll") for(int r=0;r<16;++r){o[0][r]=zz;o[1][r]=zz;o[2][r]=zz;o[3][r]=zz;negm[r]=zz;} asm volatile("":"+v"(negm));
  const int qrel=wid*QBLK+r32;
  #define CMASK(P0,P1,t) do{int jb_=(t)-(NT-4); if(jb_>=0)cmask(P0,P1,jb_,qrel,hi);}while(0)
  bool resc=false;
  #define START(P0,P1) do{ const float rm=rowmax(P0,P1); resc=false; \
    { const float dl=(rm==-INFINITY)?0.f:rm; mhat=fadd_s(mhat,dl); \
      _Pragma("unroll") for(int r=0;r<16;++r){P0[r]=fsub_s(P0[r],dl);P1[r]=fsub_s(P1[r],dl);} \
      _Pragma("unroll") for(int r=0;r<16;++r)negm[r]=-mhat; asm volatile("":"+v"(negm)); } \
    _Pragma("unroll") for(int r=0;r<16;++r)P0[r]=__builtin_amdgcn_exp2f(P0[r]); }while(0)
  #define RESC() do{ if(resc){ asm volatile("s_waitcnt lgkmcnt(0)":::"memory"); \
      _Pragma("unroll") for(int d_=0;d_<4;++d_) _Pragma("unroll") for(int r=0;r<16;++r)o[d_][r]*=wsf[crow(r,hi)]; } }while(0)
  f32x16 pA0,pA1,pB0,pB1;
  int sl_prev=S0,sl_cur=S0,sl_next=S1;
  #define ROT() do{sl_prev=sl_cur;sl_cur=sl_next;sl_next=(sl_next==(NSLOT-1)*SLOTB)?0:sl_next+SLOTB;}while(0)
  DMA_K(2,S2);
  WAIT_BAR(4);
  qkt(pA0,pA1,Kbase+S0,qr,negm,r32,hi);asm volatile("s_nop 15\n\ts_nop 7":"+v"(pA0),"+v"(pA1));MMASK(pA0,pA1,0);CMASK(pA0,pA1,0);
  START(pA0,pA1);
  _Pragma("unroll") for(int r=0;r<16;++r)pA1[r]=__builtin_amdgcn_exp2f(pA1[r]);
  WAIT_BAR(0);
  DMA_K(3,S0);DMA_V(1,S1);
  ROT();
  kload8(kf,kp0+sl_cur);
  WAIT_BAR(3);
  s16x4 vlo[4],vhi[4]; u32x4 pw0,pw1,pw2,pw3;
  #define PKW(P,B) cvtpk_s(P[B],P[B+1])
  #define PAF(k) __builtin_bit_cast(bf16x8,pw##k)
  #define VFR(i) (bf16x8){vlo[i][0],vlo[i][1],vlo[i][2],vlo[i][3],vhi[i][0],vhi[i][1],vhi[i][2],vhi[i][3]}
  #define PIN(x) asm volatile("":"+v"(x))
  #define MX3(a,b,c) __builtin_fmaxf(__builtin_fmaxf((a),(b)),(c))
  #define GAPA(MF,A0,A1,A2,A3,W0,W1,PW) do{ MF; sacc+=A0; sacc+=A1; sacc+=A2; sacc+=A3; PIN(sacc); W0; W1; PIN(PW); SBAR(); }while(0)
  #define EX(v) __builtin_amdgcn_exp2f(v)
  #define GAPB(MF,X,B) do{ MF; X[B]=EX(X[B]); X[B+1]=EX(X[B+1]); PIN(X); SBAR(); }while(0)
  #define VRDX(sl,f) do{ vlo[sl]=vtr(vp_+(((f)>>2)*4096+((f)&3)*1024)); vhi[sl]=vtr(vp_+(((f)>>2)*4096+((f)&3)*1024+512)); SBAR(); }while(0)
  #define VRD(i) do{ vlo[i]=vtr(vp_+(((i)>>2)*4096+((i)&3)*1024)); vhi[i]=vtr(vp_+(((i)>>2)*4096+((i)&3)*1024+512)); }while(0)
  #define KRD(G,j) do{ if(G){ kload2(kf,kp0+sl_next,j); SBAR(); } }while(0)
  #define STEP(C0,C1,P0,P1,t,GK,GV,GL) do{ SBAR(); \
    const lds_cptr vp_=vp0+2*sl_prev; \
    VRD(0); SBAR(); float sacc=(P0[0]+P0[1]); \
    GAPA(C0=__builtin_amdgcn_mfma_f32_32x32x16_bf16(kf[0],qr[0],negm,0,0,0), P0[2],P0[3],P0[4],P0[5],     pw0[0]=PKW(P0,0), pw0[1]=PKW(P0,2), pw0); \
    GAPA(C1=__builtin_amdgcn_mfma_f32_32x32x16_bf16(kf[1],qr[0],negm,0,0,0), P0[6],P0[7],P0[8],P0[9],     pw0[2]=PKW(P0,4), pw0[3]=PKW(P0,6), pw0); \
    VRD(1); SBAR(); GAPA(C0=__builtin_amdgcn_mfma_f32_32x32x16_bf16(kf[2],qr[1],C0,0,0,0),   P0[10],P0[11],P0[12],P0[13], pw1[0]=PKW(P0,8), pw1[1]=PKW(P0,10), pw1); \
    GAPA(C1=__builtin_amdgcn_mfma_f32_32x32x16_bf16(kf[3],qr[1],C1,0,0,0),   P0[14],P0[15],P1[0],P1[1],   pw1[2]=PKW(P0,12),pw1[3]=PKW(P0,14), pw1); \
    VRD(2); SBAR(); GAPA(C0=__builtin_amdgcn_mfma_f32_32x32x16_bf16(kf[4],qr[2],C0,0,0,0),   P1[2],P1[3],P1[4],P1[5],     pw2[0]=PKW(P1,0), pw2[1]=PKW(P1,2), pw2); \
    GAPA(C1=__builtin_amdgcn_mfma_f32_32x32x16_bf16(kf[5],qr[2],C1,0,0,0),   P1[6],P1[7],P1[8],P1[9],     pw2[2]=PKW(P1,4), pw2[3]=PKW(P1,6), pw2); \
    VRD(3); SBAR(); GAPA(C0=__builtin_amdgcn_mfma_f32_32x32x16_bf16(kf[6],qr[3],C0,0,0,0),   P1[10],P1[11],P1[12],P1[13], pw3[0]=PKW(P1,8), pw3[1]=PKW(P1,10), pw3); \
    GAPA(C1=__builtin_amdgcn_mfma_f32_32x32x16_bf16(kf[7],qr[3],C1,0,0,0),   P1[14],P1[15],0.f,0.f,       pw3[2]=PKW(P1,12),pw3[3]=PKW(P1,14), pw3); \
    l_reg+=sacc; \
    if(GK){DMA_K((t)+3,sl_cur);} if(GV){DMA_V((t)+1,sl_next);} \
    MMASK(C0,C1,t); CMASK(C0,C1,t); \
    { float a=MX3(C0[0],C0[1],C1[0]),b=MX3(C0[2],C0[3],C1[1]); a=MX3(a,C1[2],C1[3]); \
      _Pragma("unroll") for(int r=4;r<16;r+=4){a=MX3(a,C0[r],C0[r+1]);b=MX3(b,C0[r+2],C0[r+3]);a=MX3(a,C1[r],C1[r+1]);b=MX3(b,C1[r+2],C1[r+3]);} \
      float rm=__builtin_fmaxf(a,b); { auto rr=__builtin_amdgcn_permlane32_swap(__float_as_uint(rm),__float_as_uint(rm),false,false); rm=__builtin_fmaxf(__uint_as_float(rr[0]),__uint_as_float(rr[1])); } \
      resc=false; \
      if(__builtin_expect(__any(rm>(float)THRL),0)){ const float dl=__builtin_fmaxf(rm,0.f); mhat+=dl; \
        _Pragma("unroll") for(int r=0;r<16;++r){C0[r]-=dl;C1[r]-=dl;} \
        _Pragma("unroll") for(int r=0;r<16;++r)negm[r]=-mhat; asm volatile("":"+v"(negm)); \
        const float f=__builtin_amdgcn_exp2f(-dl); l_reg*=f; if(hi==0)wsf[r32]=f; resc=true; } } \
    SBAR(); \
    GAPB(o[0]=__builtin_amdgcn_mfma_f32_32x32x16_bf16(PAF(0),VFR(0),o[0],0,0,0), C0,0); VRDX(0,4); \
    GAPB(o[0]=__builtin_amdgcn_mfma_f32_32x32x16_bf16(PAF(1),VFR(1),o[0],0,0,0), C0,2); VRDX(1,5); \
    KRD(GL,0); GAPB(o[0]=__builtin_amdgcn_mfma_f32_32x32x16_bf16(PAF(2),VFR(2),o[0],0,0,0), C0,4); VRDX(2,6); \
    KRD(GL,1); GAPB(o[0]=__builtin_amdgcn_mfma_f32_32x32x16_bf16(PAF(3),VFR(3),o[0],0,0,0), C0,6); VRDX(3,7); \
    KRD(GL,2); GAPB(o[1]=__builtin_amdgcn_mfma_f32_32x32x16_bf16(PAF(0),VFR(0),o[1],0,0,0), C0,8); VRDX(0,8); \
    KRD(GL,3); GAPB(o[1]=__builtin_amdgcn_mfma_f32_32x32x16_bf16(PAF(1),VFR(1),o[1],0,0,0), C0,10); VRDX(1,9); \
    GAPB(o[1]=__builtin_amdgcn_mfma_f32_32x32x16_bf16(PAF(2),VFR(2),o[1],0,0,0), C0,12); VRDX(2,10); \
    GAPB(o[1]=__builtin_amdgcn_mfma_f32_32x32x16_bf16(PAF(3),VFR(3),o[1],0,0,0), C0,14); VRDX(3,11); \
    GAPB(o[2]=__builtin_amdgcn_mfma_f32_32x32x16_bf16(PAF(0),VFR(0),o[2],0,0,0), C1,0); VRDX(0,12); \
    GAPB(o[2]=__builtin_amdgcn_mfma_f32_32x32x16_bf16(PAF(1),VFR(1),o[2],0,0,0), C1,2); VRDX(1,13); \
    GAPB(o[2]=__builtin_amdgcn_mfma_f32_32x32x16_bf16(PAF(2),VFR(2),o[2],0,0,0), C1,4); VRDX(2,14); \
    GAPB(o[2]=__builtin_amdgcn_mfma_f32_32x32x16_bf16(PAF(3),VFR(3),o[2],0,0,0), C1,6); VRDX(3,15); \
    GAPB(o[3]=__builtin_amdgcn_mfma_f32_32x32x16_bf16(PAF(0),VFR(0),o[3],0,0,0), C1,8); \
    GAPB(o[3]=__builtin_amdgcn_mfma_f32_32x32x16_bf16(PAF(1),VFR(1),o[3],0,0,0), C1,10); \
    GAPB(o[3]=__builtin_amdgcn_mfma_f32_32x32x16_bf16(PAF(2),VFR(2),o[3],0,0,0), C1,12); \
    GAPB(o[3]=__builtin_amdgcn_mfma_f32_32x32x16_bf16(PAF(3),VFR(3),o[3],0,0,0), C1,14); \
    }while(0)
  int t=1;
  #undef CMASK
  #define CMASK(P0,P1,t) do{}while(0)
  for(;t+5<NT;t+=2){
    STEP(pB0,pB1,pA0,pA1,t,true,true,true);     WAIT_BAR(3); RESC(); ROT();
    STEP(pA0,pA1,pB0,pB1,t+1,true,true,true);   WAIT_BAR(3); RESC(); ROT();
  }
  #undef CMASK
  #define CMASK(P0,P1,t) do{int jb_=(t)-(NT-4); if(jb_>=0)cmask(P0,P1,jb_,qrel,hi);}while(0)
  #define ENDW(tt) do{ if((tt)+3<NT){WAIT_BAR(3);} else if((tt)+2<NT){WAIT_BAR(2);} else {WAIT_BAR(0);} }while(0)
  for(;t+1<NT;t+=2){
    STEP(pB0,pB1,pA0,pA1,t,(t+3<NT),(t+1<NT),(t+1<NT));       ENDW(t);   RESC(); ROT();
    STEP(pA0,pA1,pB0,pB1,t+1,(t+4<NT),(t+2<NT),(t+2<NT));     ENDW(t+1); RESC(); ROT();
  }
  STEP(pB0,pB1,pA0,pA1,NT-1,false,false,false); RESC();
  const int N0=(sl_cur==(NSLOT-1)*SLOTB)?0:sl_cur+SLOTB;
  if(nKh){ const int N1=(N0==(NSLOT-1)*SLOTB)?0:N0+SLOTB; const bf16*nks=nKh+(long)lane*PQ+wid*8; const bf16*nvs=nVh+(long)(16*(wid&3)+(lane>>2))*PQ+(wid>>2)*32+(lane&3)*8;
    glds16(nks,(unsigned)__builtin_amdgcn_readfirstlane(kdst+N0)); glds16(nvs,(unsigned)__builtin_amdgcn_readfirstlane(vdst+2*N0)); glds16(nvs+64,(unsigned)__builtin_amdgcn_readfirstlane(vdst+2*N0+8192)); glds16(nks+(long)KVBLK*PQ,(unsigned)__builtin_amdgcn_readfirstlane(kdst+N1)); }
  if(wid>=6)
  { float sacc=pB0[0]+pB0[1]; _Pragma("unroll") for(int r=2;r<16;++r)sacc+=pB0[r]; _Pragma("unroll") for(int r=0;r<16;++r)sacc+=pB1[r]; l_reg+=sacc;
    pw0=(u32x4){PKW(pB0,0),PKW(pB0,2),PKW(pB0,4),PKW(pB0,6)};pw1=(u32x4){PKW(pB0,8),PKW(pB0,10),PKW(pB0,12),PKW(pB0,14)};pw2=(u32x4){PKW(pB1,0),PKW(pB1,2),PKW(pB1,4),PKW(pB1,6)};pw3=(u32x4){PKW(pB1,8),PKW(pB1,10),PKW(pB1,12),PKW(pB1,14)};
    SBAR(); pv(o,vb0+2*sl_cur,PAF(0),PAF(1),PAF(2),PAF(3)); pv(o+2,vb0+2*sl_cur+8192,PAF(0),PAF(1),PAF(2),PAF(3)); }
  #undef PKW
  #undef PAF
  #undef VFR
  #undef PIN
  #undef MX3
  #undef GAPA
  #undef GAPB
  #undef EX
  #undef VRD
  #undef VRDX
  #undef KRD
  #undef STEP
  #undef ENDW
  {auto rr=__builtin_amdgcn_permlane32_swap(__float_as_uint(l_reg),__float_as_uint(l_reg),false,false);l_reg=__uint_as_float(rr[0])+__uint_as_float(rr[1]);}
  if(hi==0)wsf[32+r32]=l_reg;asm volatile("s_waitcnt lgkmcnt(0)":::"memory");
  float rli[16];
  #pragma unroll
  for(int r=0;r<16;++r)rli[r]=__builtin_amdgcn_rcpf(wsf[32+crow(r,hi)]);
  bf16*Ow=Ob+(long)(q0+wid*QBLK)*PO;
  { bf16*stg=(bf16*)(shm+LDS_OST)+wid*2048;
    #pragma unroll
    for(int c=0;c<2;++c){
      #pragma unroll
      for(int r=0;r<16;++r){const int orow=crow(r,hi);
        #pragma unroll
        for(int d0=0;d0<2;++d0)stg[orow*64+d0*32+r32]=__float2bfloat16(o[2*c+d0][r]*rli[r]);}
      asm volatile("s_waitcnt lgkmcnt(0)":::"memory");
      #pragma unroll
      for(int i=0;i<4;++i){const int row=i*8+(lane>>3),ch=lane&7; const u32x4 v=*(const u32x4*)(stg+row*64+ch*8); ATTN_STORE16(Ow+(long)row*PO+c*64+ch*8,v);}
      asm volatile("s_waitcnt lgkmcnt(0)":::"memory"); } }
  asm volatile("s_waitcnt lgkmcnt(0)\n\ts_barrier":::"memory");
  #undef DMA_K
  #undef DMA_V
  #undef CMASK
  #undef MMASK
  #undef START
  #undef RESC
  #undef ROT
  return N0;
}
constexpr int ATTN_LDS_BYTES=LDS_BYTES;
#undef SBAR
#undef WAIT_BAR
}


#ifndef DUP2_MOBA
#define DUP2_MOBA 0
#endif
#ifndef DUPD_HALF
#define DUPD_HALF -1
#endif
constexpr int NWAVES = 8;
constexpr int N_LAUNCHES = MK_N_LAUNCHES;
constexpr int N_PHASES = 10;
static_assert(N_LAUNCHES == 1 || N_LAUNCHES == N_PHASES, "MK_N_LAUNCHES is 1 or 10");

constexpr size_t MiB = 1u << 20;
constexpr size_t WS_CTL = 0, CTL_ZERO_BYTES = 1 * MiB;
constexpr size_t WS_ROPE = 1 * MiB;
constexpr size_t WS_KPART = 2 * MiB;
constexpr size_t WS_SSQP = 3 * MiB;
constexpr size_t WS_LIST = 56 * MiB;
constexpr size_t WS_WIN = 10 * MiB, WS_WBM = 20 * MiB, WS_WBD = 21 * MiB, WS_WOUT = 22 * MiB, WS_W13 = 24 * MiB, WS_W2 = 88 * MiB;
#ifndef WS_H8_MIB
#define WS_H8_MIB 376
#endif
constexpr size_t WS_H8 = (size_t)(WS_H8_MIB) * MiB;
constexpr size_t WS_WIN8 = 104 * MiB;
#ifndef WS_H_MIB
#define WS_H_MIB 448
#endif
constexpr size_t WS_H = (size_t)(WS_H_MIB) * MiB;
#ifndef WS_R6_MIB
#define WS_R6_MIB 184
#endif
constexpr size_t WS_R6 = (size_t)(WS_R6_MIB) * MiB;
constexpr size_t WS_QA = WS_R6, WS_KA = WS_R6 + 32 * MiB, WS_VA = WS_R6 + 64 * MiB, WS_QD = WS_R6 + 96 * MiB;
constexpr size_t WS_OA = WS_QA;
constexpr size_t WS_ODF = WS_H8;
constexpr size_t WS_MERGED = WS_QD;
constexpr size_t WS_X1F8 = WS_QA;
constexpr size_t WS_ACT = WS_KA;
constexpr size_t WS_YC = WS_VA;
#ifndef WS_GATES_MIB
#define WS_GATES_MIB 120
#endif
constexpr size_t WS_GATES = (size_t)(WS_GATES_MIB) * MiB;
constexpr size_t WS_X1 = WS_GATES;
constexpr size_t WS_END = 512 * MiB;
constexpr bool ws_disjoint(size_t a, size_t an, size_t b, size_t bn) { return a + an <= b || b + bn <= a; }
constexpr size_t SZ_H = (size_t)T * 2048, SZ_H8 = (size_t)T * 1024, SZ_GATES = (size_t)T * 2048, SZ_R6 = 6 * 32 * MiB, SZ_LOW = 120 * MiB;
static_assert(WS_W2 + (size_t)NEXP * 1024 * 512 <= WS_WIN8 && WS_WIN8 + (size_t)INC * 1024 <= SZ_LOW && WS_H + SZ_H <= WS_END && WS_H8 + SZ_H8 <= WS_END && WS_GATES + SZ_GATES <= WS_END && WS_R6 + SZ_R6 <= WS_END, "d_ws map");
static_assert(ws_disjoint(WS_H, SZ_H, WS_R6, SZ_R6) && ws_disjoint(WS_H, SZ_H, WS_GATES, SZ_GATES) && ws_disjoint(WS_H, SZ_H, WS_H8, SZ_H8) && ws_disjoint(WS_H8, SZ_H8, WS_R6, SZ_R6) && ws_disjoint(WS_H8, SZ_H8, WS_GATES, SZ_GATES) && ws_disjoint(WS_GATES, SZ_GATES, WS_R6, SZ_R6), "d_ws map");
static_assert((WS_H >= SZ_LOW) && (WS_GATES >= SZ_LOW) && (WS_H8 >= SZ_LOW || (WS_H8 == 56 * MiB)) && WS_W13 + 32 * MiB <= 56 * MiB && 88 * MiB == WS_W2, "d_ws map");
static_assert(WS_YC + (size_t)2 * T * 1024 <= WS_R6 + SZ_R6 && WS_ACT + (size_t)2 * T * 512 <= WS_YC && WS_X1F8 + (size_t)T * 1024 <= WS_ACT && WS_LIST + (size_t)NEXP * LISTCAP * 16 <= WS_W2 && WS_LIST >= WS_W13 + 32 * MiB && (WS_H8 >= SZ_LOW), "d_ws overlays");
constexpr int CW_TMO = 0, CW_CODE = 1;
constexpr int CW_BAR = 4096;
constexpr int CW_CNT = 8192;

constexpr int RING_OFF = 0, RING_BYTES = 131072;
constexpr int LDSCTL_OFF = RING_BYTES, MISC_OFF = LDSCTL_OFF + 320;
constexpr int LDS_BYTES = 147456;
static_assert(MISC_OFF + 128 <= LDS_BYTES, "LDS map");

#define GAS __attribute__((address_space(1)))
#define LAS __attribute__((address_space(3)))
typedef unsigned short bf16;
typedef unsigned v4u __attribute__((ext_vector_type(4)));
typedef float f32x4 __attribute__((ext_vector_type(4)));
typedef short bf16x8 __attribute__((ext_vector_type(8)));
typedef GAS unsigned gu32;
typedef GAS unsigned long long gu64;
#define RLX_AGENT __ATOMIC_RELAXED, __HIP_MEMORY_SCOPE_AGENT
#define LDS_WAIT() asm volatile("s_waitcnt lgkmcnt(0)" ::: "memory")
#define VM_WAIT() asm volatile("s_waitcnt vmcnt(0)" ::: "memory")
__device__ __forceinline__ unsigned long long rt() { return __builtin_amdgcn_s_memrealtime(); }
__device__ __forceinline__ unsigned f2bf(float f) { unsigned u = __builtin_bit_cast(unsigned, f); return (u + 0x7fffu + ((u >> 16) & 1u)) >> 16; }
__device__ __forceinline__ unsigned pk2(float lo, float hi) { return f2bf(lo) | (f2bf(hi) << 16); }

#define XB_TMO      128
#define XB_XCNT(j)  (256  + 64 * (j))
#define XB_XSUB(j)  (1280 + 64 * (j))
#define XB_XGEN(j)  (2304 + 64 * (j))
#define XB_TOP      3328
#define XB_TOPGEN   3392
#define XCD_BAR_WORDS 3456
#define XB_SPIN_CAP (1u << 18)

__device__ __forceinline__ unsigned xb_ld(unsigned* p)              { return __hip_atomic_load(p, __ATOMIC_RELAXED, __HIP_MEMORY_SCOPE_AGENT); }
__device__ __forceinline__ unsigned xb_add(unsigned* p, unsigned v) { return __hip_atomic_fetch_add(p, v, __ATOMIC_RELAXED, __HIP_MEMORY_SCOPE_AGENT); }
__device__ __forceinline__ unsigned xb_xcc_id() { return (unsigned)__builtin_amdgcn_s_getreg((3 << 11) | 20) & 0xFu; }
#define XB_SPIN(cond, bar) do { unsigned _sp = 0; while (cond) { __builtin_amdgcn_s_sleep(1); \
    if ((++_sp & 255u) == 0u) { if (xb_ld(&(bar)[XB_TMO])) break; if (_sp > XB_SPIN_CAP) { atomicAdd(&(bar)[XB_TMO], 1u); break; } } } } while (0)

struct XcdBarrier {
    unsigned* bar; unsigned x;
    volatile LAS unsigned* st;
};

__device__ __forceinline__ XcdBarrier xcd_barrier_post(unsigned* bar, volatile LAS unsigned* st) {
    XcdBarrier b; b.bar = bar; b.x = xb_xcc_id(); b.st = st;
    if (threadIdx.x == 0) (void)xb_add(&bar[XB_XCNT(b.x)], 1u);
    return b;
}
__device__ __forceinline__ void xcd_barrier_complete(unsigned* bar, unsigned x, unsigned& nloc, unsigned& nx) {
    const unsigned G = gridDim.x * gridDim.y * gridDim.z;
    unsigned sum, cnt, mine, sp = 0u;
    for (;;) {
        sum = 0u; cnt = 0u; mine = 0u;
#pragma unroll
        for (unsigned j = 0; j < 16; ++j) { const unsigned c = xb_ld(&bar[XB_XCNT(j)]); sum += c; cnt += (c > 0u) ? 1u : 0u; mine = (j == x) ? c : mine; }
        if (sum == G) break;
        __builtin_amdgcn_s_sleep(1);
        if ((++sp & 255u) == 0u) { if (xb_ld(&bar[XB_TMO])) break; if (sp > XB_SPIN_CAP) { atomicAdd(&bar[XB_TMO], 1u); break; } }
    }
    nloc = mine > 0u ? mine : 1u; nx = cnt > 0u ? cnt : 1u;
}

__device__ __forceinline__ void xcd_barrier(const XcdBarrier& b) {
    asm volatile("s_waitcnt vmcnt(0)" ::: "memory");
    __syncthreads();
    if (threadIdx.x == 0) {
        unsigned* bar = b.bar;
        __builtin_amdgcn_s_waitcnt(0);
        unsigned nloc = b.st[0], nx = b.st[1];
        if (nloc == 0u) { xcd_barrier_complete(bar, b.x, nloc, nx); b.st[0] = nloc; b.st[1] = nx; }
        const unsigned old = xb_add(&bar[XB_XSUB(b.x)], 1u);
        const unsigned gen = old / nloc;
        if (old + 1u == (gen + 1u) * nloc) {
            __builtin_amdgcn_fence(__ATOMIC_RELEASE, "agent");
            asm volatile("s_waitcnt vmcnt(0)" ::: "memory");
            const unsigned og = xb_add(&bar[XB_TOP], 1u);
            const unsigned tg = og / nx;
            if (og + 1u == (tg + 1u) * nx) xb_add(&bar[XB_TOPGEN], 1u);
            else XB_SPIN(xb_ld(&bar[XB_TOPGEN]) == tg, bar);
            __builtin_amdgcn_fence(__ATOMIC_ACQUIRE, "agent");
            xb_add(&bar[XB_XGEN(b.x)], 1u);
            asm volatile("s_waitcnt vmcnt(0)" ::: "memory");
        } else {
            XB_SPIN(xb_ld(&bar[XB_XGEN(b.x)]) == gen, bar);
            __builtin_amdgcn_fence(__ATOMIC_ACQUIRE, "agent");
            asm volatile("s_waitcnt vmcnt(0)" ::: "memory");
        }
    }
    __syncthreads();
}

struct Args { const float* in[20]; float* out; unsigned char* ws; int ph_lo, ph_hi; };

template <class F> __device__ __forceinline__ void xcd_barrier_work(const XcdBarrier& b, F&& f) {
    asm volatile("s_waitcnt vmcnt(0)" ::: "memory");
    __syncthreads();
    if (threadIdx.x == 0) {
        unsigned* bar = b.bar;
        __builtin_amdgcn_s_waitcnt(0);
        unsigned nloc = b.st[0], nx = b.st[1];
        if (nloc == 0u) { xcd_barrier_complete(bar, b.x, nloc, nx); b.st[0] = nloc; b.st[1] = nx; }
        const unsigned old = xb_add(&bar[XB_XSUB(b.x)], 1u);
        const unsigned gen = old / nloc;
        if (old + 1u == (gen + 1u) * nloc) {
            __builtin_amdgcn_fence(__ATOMIC_RELEASE, "agent");
            asm volatile("s_waitcnt vmcnt(0)" ::: "memory");
            const unsigned og = xb_add(&bar[XB_TOP], 1u);
            const unsigned tg = og / nx;
            if (og + 1u == (tg + 1u) * nx) xb_add(&bar[XB_TOPGEN], 1u);
            else XB_SPIN(xb_ld(&bar[XB_TOPGEN]) == tg, bar);
            __builtin_amdgcn_fence(__ATOMIC_ACQUIRE, "agent");
            xb_add(&bar[XB_XGEN(b.x)], 1u);
            asm volatile("s_waitcnt vmcnt(0)" ::: "memory");
        } else {
            XB_SPIN(xb_ld(&bar[XB_XGEN(b.x)]) == gen, bar);
            __builtin_amdgcn_fence(__ATOMIC_ACQUIRE, "agent");
            asm volatile("s_waitcnt vmcnt(0)" ::: "memory");
        }
    } else if (threadIdx.x >= 64) f((int)threadIdx.x - 64, NWAVES * 64 - 64);
    __syncthreads();
}

typedef float f32x16 __attribute__((ext_vector_type(16)));
typedef unsigned u32x2 __attribute__((ext_vector_type(2)));
typedef float f32x2v __attribute__((ext_vector_type(2)));

__device__ __forceinline__ float wave_sum(float v) {
#pragma unroll
    for (int o = 1; o < 64; o <<= 1) v += __shfl_xor(v, o);
    return v;
}
__device__ __forceinline__ float bf2f_lo(unsigned w) { return __builtin_bit_cast(float, w << 16); }
__device__ __forceinline__ float bf2f_hi(unsigned w) { return __builtin_bit_cast(float, w & 0xffff0000u); }

__device__ __forceinline__ int rowmap(int code, int n0) {
    if (code == 1) { const int pn = n0 >> 8; const bool rope = (pn < 4) || (pn >= 6 && pn < 10); if (!rope) return n0; const int hh = (n0 & 255) >> 6, half = (n0 & 63) >> 5; return (pn << 8) + 64 * hh + 8 * half; }
    if (code == 2) return 256 * (n0 >> 7) + 64 * ((n0 & 127) >> 5);
    if (code == 3) return 256 * (n0 >> 7) + 64 * ((n0 & 127) >> 5) + 8;
    return n0;
}
__device__ __forceinline__ int rowstep(int code, int n0) {
    if (code == 1) { const int pn = n0 >> 8; const bool rope = (pn < 4) || (pn >= 6 && pn < 10); return rope ? 16 : 8; }
    return (code == 2 || code == 3) ? 16 : 8;
}
struct P0Item { const float* W; unsigned char* dst; const float* kscale; float scale; int N, K, k0, n0, r0, f8, rs; };
__device__ __forceinline__ P0Item p0_decode(const Args& A, int it) {
    constexpr int I_IN = 16 * 160, I_BM = 8 * 32, I_OUT = 16 * 32, I_E = 256;
    unsigned char* ws = A.ws; P0Item d; d.kscale = nullptr; d.scale = 1.f; d.f8 = 0; int code = 0, item = it, r = it;
    if (r < I_IN) { const int pn = (r % 160) >> 3; d.W = A.in[2]; d.K = 1024; d.N = INC; code = 1; if (pn < 6 || pn >= 6 + pg8::P1_NB) { d.f8 = 1; d.scale = pn >= 12 ? -64.f * 1.4426950408889634f : 64.f; d.dst = ws + WS_WIN8; }     else d.dst = ws + WS_WIN; }
    else if ((r -= I_IN) < I_BM) { d.W = A.in[3]; d.K = 512; d.N = 1024; d.dst = ws + WS_WBM; item = r; }
    else if ((r -= I_BM) < I_BM) { d.W = A.in[4]; d.K = 512; d.N = 1024; d.dst = ws + WS_WBD; item = r; }
    else if ((r -= I_BM) < I_OUT) { d.W = A.in[5]; d.K = 1024; d.N = 1024; d.dst = ws + WS_WOUT; item = r; }
    else if ((r -= I_OUT) < NEXP * I_E) { const int e = r >> 8; d.W = A.in[16] + (size_t)e * 1024 * 512; d.K = 1024; d.N = 512; d.dst = ws + WS_W13 + (size_t)e * 1024 * 1024; code = 2; d.f8 = 1; d.scale = 64.f; d.kscale = A.in[11]; item = r & 255; }
    else if ((r -= NEXP * I_E) < NEXP * I_E) { const int e = r >> 8; d.W = A.in[17] + (size_t)e * 1024 * 512; d.K = 1024; d.N = 512; d.dst = ws + WS_W13 + (size_t)e * 1024 * 1024; code = 3; d.f8 = 1; d.scale = 64.f; d.kscale = A.in[11]; item = r & 255; }
    else { r -= NEXP * I_E; const int e = r >> 8; d.W = A.in[18] + (size_t)e * 512 * 1024; d.K = 512; d.N = 1024; d.dst = ws + WS_W2 + (size_t)e * 1024 * 512; d.f8 = 1; d.scale = 32.f; item = r & 255; }
    const int nblk = d.N / 32, kb = item / nblk, nb = item % nblk; d.k0 = 64 * kb; d.n0 = 32 * nb; d.r0 = rowmap(code, d.n0); d.rs = rowstep(code, d.n0);
    return d;
}
__device__ __forceinline__ void p0_load(const P0Item& d, float (&wv)[32], int lane) {
#pragma unroll
    for (int i = 0; i < 32; ++i) { const int kk = 2 * i + (lane >> 5); wv[i] = __builtin_nontemporal_load(d.W + (size_t)(d.k0 + kk) * d.N + d.n0 + (lane & 31)); }
}
__device__ __forceinline__ void p0_finish(const P0Item& d, const float (&wv)[32], LAS float* scr, int lane) {
#pragma unroll
    for (int i = 0; i < 32; ++i) { const int kk = 2 * i + (lane >> 5); scr[kk * 33 + (lane & 31)] = wv[i]; }
    LDS_WAIT(); asm volatile("" ::: "memory");
    if (d.f8) {
        const int c = lane & 3;
        float gs[16];
#pragma unroll
        for (int q = 0; q < 16; ++q) gs[q] = d.kscale ? d.kscale[d.k0 + 16 * c + q] * d.scale : d.scale;
#pragma unroll
        for (int j = 0; j < 2; ++j) { const int n = (lane >> 2) + 16 * j; const LAS float* s = scr + (16 * c) * 33 + n;
            v4u o;
#pragma unroll
            for (int q = 0; q < 4; ++q) { int w = 0; w = __builtin_amdgcn_cvt_pk_fp8_f32(s[(4 * q) * 33] * gs[4 * q], s[(4 * q + 1) * 33] * gs[4 * q + 1], w, false);
                w = __builtin_amdgcn_cvt_pk_fp8_f32(s[(4 * q + 2) * 33] * gs[4 * q + 2], s[(4 * q + 3) * 33] * gs[4 * q + 3], w, true); o[q] = (unsigned)w; }
            *(GAS v4u*)(d.dst + (size_t)(d.r0 + (n & 7) + d.rs * (n >> 3)) * d.K + d.k0 + 16 * c) = o; }
    } else {
        const int c = lane & 7;
#pragma unroll
        for (int j = 0; j < 4; ++j) { const int n = (lane >> 3) + 8 * j; const LAS float* s = scr + (8 * c) * 33 + n;
            v4u o; o.x = pk2(s[0 * 33], s[1 * 33]); o.y = pk2(s[2 * 33], s[3 * 33]); o.z = pk2(s[4 * 33], s[5 * 33]); o.w = pk2(s[6 * 33], s[7 * 33]);
            *(GAS v4u*)((bf16*)d.dst + (size_t)(d.r0 + (n & 7) + d.rs * (n >> 3)) * d.K + d.k0 + 8 * c) = o; }
    }
    LDS_WAIT(); asm volatile("" ::: "memory");
}
constexpr int P0_NITEMS = 16 * 160 + 2 * 8 * 32 + 16 * 32 + 3 * NEXP * 256, P0_FIXED = 16 * 160 + 2 * 8 * 32 + 16 * 32;
constexpr int P0_W2_FIRST = P0_FIXED + 2 * NEXP * 256, P0_W2_N = NEXP * 256;
__device__ __forceinline__ void p0_run(const Args& A, LAS float* scr, int lane, int j0, int step, int jend, int base) {
    if (j0 >= jend) return;
    float wA[32], wB[32]; P0Item dA = p0_decode(A, base + j0), dB = dA; int jA = j0;
    p0_load(dA, wA, lane);
    for (;;) {
        const int jB = jA + step; const bool hasB = jB < jend;
        if (hasB) { dB = p0_decode(A, base + jB); p0_load(dB, wB, lane); }
        p0_finish(dA, wA, scr, lane);
        if (!hasB) break;
        jA = jB + step; const bool hasA = jA < jend;
        if (hasA) { dA = p0_decode(A, base + jA); p0_load(dA, wA, lane); }
        p0_finish(dB, wB, scr, lane);
        if (!hasA) break;
    }
}
#ifndef SH_IPW2
#define SH_IPW2 4
#endif
constexpr int P0_POOL0 = 16 * 160, P0_POOLN = 2 * 8 * 32 + 16 * 32 + 2 * NEXP * 256;
__device__ __forceinline__ int sh_ipw(int s) { return s == 2 ? SH_IPW2 : 2; }
__device__ __forceinline__ int sh_off(int s, int G) { int o = 0; for (int i = 0; i < s; ++i) o += sh_ipw(i); return o * 7 * G; }
__device__ __forceinline__ int sh_cover(int G) { const int c = sh_off(4, G); return c < P0_POOLN ? c : P0_POOLN; }
__device__ __forceinline__ void p0_shadow(LAS unsigned char* lds, const Args& A, int vcu, int G, int s, int t) {
    const int lane = t & 63, w = __builtin_amdgcn_readfirstlane(t >> 6);
    LAS float* scr = (LAS float*)(lds + RING_OFF + (w + 1) * 16384);
    const int off = sh_off(s, G), left = sh_cover(G) - off, n = sh_ipw(s) * 7 * G;
    p0_run(A, scr, lane, vcu * 7 + w, 7 * G, n < left ? n : left, P0_POOL0 + off);
}
__device__ __forceinline__ void p0_tail_w2(LAS unsigned char* lds, const Args& A, int vcu, int G, int total, int tid) {
    const int lane = tid & 63, w = __builtin_amdgcn_readfirstlane(tid >> 6);
    LAS float* scr = (LAS float*)(lds + RING_OFF + w * 16384);
    const int maxU = (total + G - 1) / G, nlong = total - (maxU - 1) * G, nshort = nlong >= G ? 0 : G - nlong;
    int Tn = nshort * NWAVES * 8; Tn = Tn < P0_W2_N ? Tn : P0_W2_N;
    if (vcu >= nlong) p0_run(A, scr, lane, (vcu - nlong) * NWAVES + w, nshort * NWAVES, Tn, P0_W2_FIRST);
    p0_run(A, scr, lane, Tn + vcu * NWAVES + w, G * NWAVES, P0_W2_N, P0_W2_FIRST);
}
__device__ __forceinline__ void p0_prologue(LAS unsigned char* lds, const Args& A, int vcu, int G, int tid, int nsh) {
    const int lane = tid & 63, wave = __builtin_amdgcn_readfirstlane(tid >> 6);
    unsigned char* ws = A.ws;
    LAS float* scr = (LAS float*)(lds + RING_OFF + wave * 16384);
    const int gw = vcu * NWAVES + wave, NGW = G * NWAVES;
    const int skip = nsh > 0 ? sh_cover(G) : 0, NITEMS = (nsh > 0 ? P0_W2_FIRST : P0_NITEMS) - skip;
#define P0_MAP(j) ((j) < P0_POOL0 ? (j) : (j) + skip)
    if (gw < NITEMS) {
        float wA[32], wB[32]; P0Item dA = p0_decode(A, P0_MAP(gw)), dB = dA; int itA = gw;
        p0_load(dA, wA, lane);
        for (;;) {
            const int itB = itA + NGW; const bool hasB = itB < NITEMS;
            if (hasB) { dB = p0_decode(A, P0_MAP(itB)); p0_load(dB, wB, lane); }
            p0_finish(dA, wA, scr, lane);
            if (!hasB) break;
            itA = itB + NGW; const bool hasA = itA < NITEMS;
            if (hasA) { dA = p0_decode(A, P0_MAP(itA)); p0_load(dA, wA, lane); }
            p0_finish(dB, wB, scr, lane);
            if (!hasA) break;
        }
    }
#undef P0_MAP
    { const float* gm = A.in[1]; f32x4 gv[4];
#pragma unroll
        for (int j = 0; j < 4; ++j) gv[j] = ((const GAS f32x4*)gm)[lane + 64 * j];
        bf16* H = (bf16*)(ws + WS_H); unsigned char* H8 = (unsigned char*)(ws + WS_H8);
        for (int m = gw; m < T; m += 2 * NGW) {
            const int m2 = m + NGW;
            const GAS f32x4* xr = (const GAS f32x4*)(A.in[0] + (size_t)m * DM) + lane; const GAS f32x4* xr2 = (const GAS f32x4*)(A.in[0] + (size_t)(m2 < T ? m2 : m) * DM) + lane;
            f32x4 v[4], u[4]; float s = 0.f, s2 = 0.f;
#pragma unroll
            for (int j = 0; j < 4; ++j) { v[j] = __builtin_nontemporal_load(xr + 64 * j); u[j] = __builtin_nontemporal_load(xr2 + 64 * j); }
#pragma unroll
            for (int j = 0; j < 4; ++j) { s += (v[j].x * v[j].x + v[j].y * v[j].y) + (v[j].z * v[j].z + v[j].w * v[j].w); s2 += (u[j].x * u[j].x + u[j].y * u[j].y) + (u[j].z * u[j].z + u[j].w * u[j].w); }
            const float rstd = 1.0f / sqrtf(wave_sum(s) * (1.f / DM) + EPS), rstd2 = 1.0f / sqrtf(wave_sum(s2) * (1.f / DM) + EPS);
            GAS unsigned long long* o8 = (GAS unsigned long long*)(H + (size_t)m * DM) + lane;
#pragma unroll
            for (int j = 0; j < 4; ++j) { const f32x4 o = v[j] * rstd * gv[j]; if constexpr (pg8::P1_NB > 0) o8[64 * j] = (unsigned long long)pk2(o.x, o.y) | ((unsigned long long)pk2(o.z, o.w) << 32);
                int w = 0; w = __builtin_amdgcn_cvt_pk_fp8_f32(o.x, o.y, w, false); w = __builtin_amdgcn_cvt_pk_fp8_f32(o.z, o.w, w, true); ((GAS unsigned*)(H8 + (size_t)m * DM))[lane + 64 * j] = (unsigned)w; }
            if (m2 < T) { GAS unsigned long long* p8 = (GAS unsigned long long*)(H + (size_t)m2 * DM) + lane;
#pragma unroll
                for (int j = 0; j < 4; ++j) { const f32x4 o = u[j] * rstd2 * gv[j]; if constexpr (pg8::P1_NB > 0) p8[64 * j] = (unsigned long long)pk2(o.x, o.y) | ((unsigned long long)pk2(o.z, o.w) << 32);
                    int w = 0; w = __builtin_amdgcn_cvt_pk_fp8_f32(o.x, o.y, w, false); w = __builtin_amdgcn_cvt_pk_fp8_f32(o.z, o.w, w, true); ((GAS unsigned*)(H8 + (size_t)m2 * DM))[lane + 64 * j] = (unsigned)w; } }
        }
    }
    if (vcu == 0 && tid < 256) ((float*)(ws + WS_ROPE))[2 * SEQ * 32 + tid] = A.in[6 + (tid >> 6)][tid & 63];
    { float* cosT = (float*)(ws + WS_ROPE); float* sinT = cosT + SEQ * 32;
        for (int idx = vcu * (NWAVES * 64) + tid; idx < SEQ * 32; idx += G * NWAVES * 64) { const int s = idx >> 5, d = idx & 31;
            const float inv = 1.0f / powf(10000.0f, (float)(2 * d) / 64.0f); const float ang = (float)s * inv; cosT[idx] = cosf(ang); sinT[idx] = sinf(ang); } }
}

template <bool DO_MOBA, bool DO_DIFF> __device__ __forceinline__ void p2_attention(char* lds, unsigned char* ws, int vcu, int G, void* oa_override, const float* lp  , const float* subg) {
    using attn_body::bf16;
    const bf16* QA = (const bf16*)(ws + WS_QA); const bf16* QD = (const bf16*)(ws + WS_QD);
    const float* kpart = (const float*)(ws + WS_KPART);
    constexpr size_t R = (size_t)T * 512;
    if constexpr (DO_MOBA) { constexpr int NP = BATCH * 8 * 4; const int per = (NP + G - 1) / G; const int pend = (vcu + 1) * per < NP ? (vcu + 1) * per : NP;
        int bh_built = -1; int s0m = 0; bool prem = false;
        for (int p = vcu * per; p < pend; ++p) { const int bh = p >> 2, s = p & 3, b = bh >> 3, h = bh & 7; const size_t ro = (size_t)b * SEQ * 512 + h * 64;
            if (bh != bh_built) {
                const int tid = threadIdx.x, lane = tid & 63, r32 = lane & 31, hi = lane >> 5;
                __syncthreads();
                if (tid < 64) { const float* k0 = kpart + (((size_t)b) * 8 + h) * 512; const float* k1 = kpart + (((size_t)16 + b) * 8 + h) * 512; const int jr = r32 & 7; const float kz = (r32 < 8) ? (1.f / 256.f) : 0.f;
#pragma unroll
                    for (int d0 = 0; d0 < 4; ++d0) { const float* p0 = k0 + jr * 64 + d0 * 16 + hi * 8; const float* p1 = k1 + jr * 64 + d0 * 16 + hi * 8;
                        const f32x4 a0 = *(const GAS f32x4*)p0, a1 = *(const GAS f32x4*)(p0 + 4), b0 = *(const GAS f32x4*)p1, b1 = *(const GAS f32x4*)(p1 + 4);
                        v4u w; w.x = pk2((a0.x + b0.x) * kz, (a0.y + b0.y) * kz); w.y = pk2((a0.z + b0.z) * kz, (a0.w + b0.w) * kz); w.z = pk2((a1.x + b1.x) * kz, (a1.y + b1.y) * kz); w.w = pk2((a1.z + b1.z) * kz, (a1.w + b1.w) * kz);
                        *(LAS v4u*)((LAS unsigned char*)(unsigned)(uintptr_t)lds + 90112 + d0 * 1024 + lane * 16) = w; } }
                __syncthreads(); bh_built = bh; }
            for (int half = 0; half < 2; ++half) { const int qb = half ? 7 - s : s;
                const bf16* nK = nullptr; const bf16* nV = nullptr;
                if (half == 0) { nK = QA + R + ro; nV = QA + 2 * R + ro; }
                else if (p + 1 < pend) { const int bh2 = (p + 1) >> 2; const size_t ro2 = (size_t)(bh2 >> 3) * SEQ * 512 + (bh2 & 7) * 64; if (bh2 == bh) { nK = QA + R + ro2; nV = QA + 2 * R + ro2; } }
                s0m = attn_body::attn_unit<8, true, 512, (DUP2_MOBA == 2) && !DO_DIFF>(qb, QA + ro, QA + R + ro, QA + 2 * R + ro, (oa_override ? (bf16*)oa_override : (bf16*)(ws + WS_OA)) + ro, (const float*)(lds + 90112), nullptr, lds, s0m, prem, nK, nV);
                prem = (nK != nullptr); } } }
    if constexpr (DO_DIFF) { constexpr int NP = BATCH * 4 * 4; const int per = (NP + G - 1) / G; const int pend = (vcu + 1) * per < NP ? (vcu + 1) * per : NP;
        for (int p = vcu * per; p < pend; ++p) { const int b = p >> 4, hd = (p >> 2) & 3, s = p & 3; const size_t rb = (size_t)b * SEQ;
            int s0d = 0; bool pred = false;
            for (int half = 0; half < 2; ++half) { const int qb = half ? 7 - s : s;
                if (!DO_MOBA && DUPD_HALF >= 0 && half != DUPD_HALF) continue;
                for (int m = 0; m < 2; ++m) {
                    const bf16* Kc = QD + R + rb * 512 + (hd * 2 + m) * 64; const bf16* Vc = QD + 2 * R + rb * 512 + hd * 128;
                    const bf16* nK = nullptr; const bf16* nV = nullptr;
                    if (m == 0) { nK = QD + R + rb * 512 + (hd * 2 + 1) * 64; nV = Vc; } else if (half == 0) { nK = QD + R + rb * 512 + (hd * 2 + 0) * 64; nV = Vc; }
                    s0d = attn_body::attn_unit128<8, 1024>(qb, QD + rb * 512 + (hd * 2 + m) * 64, Kc, Vc, (bf16*)(ws + WS_H) + rb * 1024 + (hd * 4 + m * 2) * 64, lds, s0d, pred, nK, nV);
                    pred = (nK != nullptr); } }
            asm volatile("s_waitcnt vmcnt(0)" ::: "memory"); __syncthreads();
            if (threadIdx.x == 0) { __builtin_amdgcn_fence(__ATOMIC_ACQUIRE, "agent"); asm volatile("s_waitcnt vmcnt(0)" ::: "memory"); }
            __syncthreads();
            { int tid = threadIdx.x; asm volatile("" : "+v"(tid));
                const int lane = tid & 63, wave = __builtin_amdgcn_readfirstlane(tid >> 6);
                const float lam = __expf(wave_sum(lp[lane] * lp[64 + lane])) - __expf(wave_sum(lp[128 + lane] * lp[192 + lane])) + 0.2f;
                const int e0 = (lane & 15) * 8, cc = e0 >> 6, d0 = e0 & 63; float g[8];
#pragma unroll
                for (int j = 0; j < 8; ++j) g[j] = subg[e0 + j] * 0.8f;
                const unsigned short* OD = (const unsigned short*)(ws + WS_H); unsigned short* OF = (unsigned short*)(ws + WS_ODF);
                for (int it0 = wave; it0 < 128; it0 += 4 * NWAVES) {
                    v4u av[4], bv[4]; size_t rowv[4];
#pragma unroll
                    for (int q = 0; q < 4; ++q) { const int it = it0 + q * NWAVES, rr = it * 4 + (lane >> 4), qb = (rr >> 8) ? 7 - s : s; rowv[q] = rb + (size_t)qb * 256 + (rr & 255);
                        av[q] = *(const GAS v4u*)(OD + rowv[q] * 1024 + (hd * 4 + cc) * 64 + d0); bv[q] = *(const GAS v4u*)(OD + rowv[q] * 1024 + (hd * 4 + 2 + cc) * 64 + d0); }
#pragma unroll
                    for (int q = 0; q < 4; ++q) { const v4u a = av[q], bq = bv[q]; const size_t row = rowv[q];
                        float v[8];
#pragma unroll
                        for (int j = 0; j < 4; ++j) { v[2 * j] = bf2f_lo(a[j]) - lam * bf2f_lo(bq[j]); v[2 * j + 1] = bf2f_hi(a[j]) - lam * bf2f_hi(bq[j]); }
                        float ss = 0.f;
#pragma unroll
                        for (int j = 0; j < 8; ++j) ss += v[j] * v[j];
                        ss += __shfl_xor(ss, 1); ss += __shfl_xor(ss, 2); ss += __shfl_xor(ss, 4); ss += __shfl_xor(ss, 8);
                        const float rstd = 1.0f / sqrtf(ss * (1.f / 128.f) + EPS);
                        v4u o;
#pragma unroll
                        for (int j = 0; j < 4; ++j) o[j] = pk2(v[2 * j] * rstd * g[2 * j], v[2 * j + 1] * rstd * g[2 * j + 1]);
                        *(GAS v4u*)(OF + row * 512 + hd * 128 + e0) = o; } } }
        } }
}

__device__ __forceinline__ void p3_combine(const Args& A, int vcu, int G, int tid) {
    const int lane = tid & 63, wave = __builtin_amdgcn_readfirstlane(tid >> 6);
    const int gw = vcu * NWAVES + wave, NGW = G * NWAVES;
    const float lam = __expf(wave_sum(A.in[6][lane] * A.in[7][lane])) - __expf(wave_sum(A.in[8][lane] * A.in[9][lane])) + 0.2f;
    const int hd = lane >> 4, e0 = (lane & 15) * 8, c = e0 >> 6, d0 = e0 & 63;
    float g[8];
#pragma unroll
    for (int j = 0; j < 8; ++j) g[j] = A.in[10][e0 + j] * 0.8f;
    const bf16* OD = (const bf16*)(A.ws + WS_H); bf16* OF = (bf16*)(A.ws + WS_ODF);
    for (int row = gw; row < T; row += NGW) {
        const v4u a = *(const GAS v4u*)(OD + (size_t)row * 1024 + (hd * 4 + c) * 64 + d0), b = *(const GAS v4u*)(OD + (size_t)row * 1024 + (hd * 4 + 2 + c) * 64 + d0);
        float v[8];
#pragma unroll
        for (int j = 0; j < 4; ++j) { v[2 * j] = bf2f_lo(a[j]) - lam * bf2f_lo(b[j]); v[2 * j + 1] = bf2f_hi(a[j]) - lam * bf2f_hi(b[j]); }
        float ss = 0.f;
#pragma unroll
        for (int j = 0; j < 8; ++j) ss += v[j] * v[j];
        ss += __shfl_xor(ss, 1); ss += __shfl_xor(ss, 2); ss += __shfl_xor(ss, 4); ss += __shfl_xor(ss, 8);
        const float rstd = 1.0f / sqrtf(ss * (1.f / 128.f) + EPS);
        v4u o;
#pragma unroll
        for (int j = 0; j < 4; ++j) o[j] = pk2(v[2 * j] * rstd * g[2 * j], v[2 * j + 1] * rstd * g[2 * j + 1]);
        *(GAS v4u*)(OF + (size_t)row * 512 + hd * 128 + e0) = o;
    }
}

__device__ __forceinline__ void p6_prep(LAS unsigned char* lds, const Args& A, int t, int n) {
    constexpr int WLS = 1032; LAS bf16* Wl = (LAS bf16*)lds;
    const float* wgroup = A.in[12]; const float* wrouter = A.in[14]; const float* gf = A.in[11];
    for (int idx = t; idx < 32 * 1024; idx += n) { const int e = idx & 31, k = idx >> 5; Wl[(4 + e) * WLS + k] = (bf16)f2bf(wrouter[idx] * gf[k]); }
    for (int idx = t; idx < 4 * 1024; idx += n) { const int nn = idx & 3, k = idx >> 2; Wl[nn * WLS + k] = (bf16)f2bf(wgroup[idx] * gf[k]); }
}
__device__ __forceinline__ void p6_router(LAS unsigned char* lds, const Args& A, int vcu, int G, int tid, bool prepped) {
    const int lane = tid & 63, wave = __builtin_amdgcn_readfirstlane(tid >> 6), r32 = lane & 31, hi = lane >> 5;
    constexpr int WLS = 1032;
    LAS bf16* Wl = (LAS bf16*)lds;
    LAS int* lcnt = (LAS int*)(lds + 36 * WLS * 2); LAS int* lbase = lcnt + 32; LAS float* xch = (LAS float*)(lds + 36 * WLS * 2 + 256);
    const float* bgroup = A.in[13]; const float* brouter = A.in[15];
    if (!prepped) p6_prep(lds, A, tid, NWAVES * 64);
    __syncthreads();
    const bf16* x1g = (const bf16*)(A.ws + WS_H); const float* ssqp = (const float*)(A.ws + WS_SSQP);
    unsigned* cnt = (unsigned*)(A.ws + WS_CTL) + CW_CNT; unsigned* list = (unsigned*)(A.ws + WS_LIST);
    for (int chunk = vcu; chunk < T / 128; chunk += G) {
        if (tid < 32) lcnt[tid] = 0;
        __syncthreads();
        const int row = chunk * 128 + (wave & 3) * 32 + r32;
        int e1 = 0, e2 = 0, p1 = 0, p2 = 0; float w1 = 0.f, w2 = 0.f, rs = 0.f;
        f32x16 acc0 = {}, acc1 = {}; f32x4 sq[4];
        { const bf16* xp = x1g + (size_t)row * 1024 + hi * 8 + (wave >> 2) * 512;
            const LAS bf16* ap0 = Wl + (4 + r32) * WLS + hi * 8 + (wave >> 2) * 512; const LAS bf16* ap1 = Wl + (r32 & 3) * WLS + hi * 8 + (wave >> 2) * 512;
            bf16x8 bA[8], bB[8], bC[8], bD[8];
#define P6_LOADB(B, s0) do { _Pragma("unroll") for (int j = 0; j < 8; ++j) B[j] = *(const GAS bf16x8*)(xp + ((s0) + j) * 16); } while (0)
#define P6_MMA(B, s0) do { _Pragma("unroll") for (int j = 0; j < 8; ++j) { const bf16x8 a0 = *(const LAS bf16x8*)(ap0 + ((s0) + j) * 16); bf16x8 a1 = *(const LAS bf16x8*)(ap1 + ((s0) + j) * 16); if (r32 >= 4) a1 = (bf16x8){0, 0, 0, 0, 0, 0, 0, 0}; \
                acc0 = __builtin_amdgcn_mfma_f32_32x32x16_bf16(a0, B[j], acc0, 0, 0, 0); acc1 = __builtin_amdgcn_mfma_f32_32x32x16_bf16(a1, B[j], acc1, 0, 0, 0); } } while (0)
            P6_LOADB(bA, 0); P6_LOADB(bB, 8); P6_LOADB(bC, 16); P6_LOADB(bD, 24);
#pragma unroll
            for (int q = 0; q < 4; ++q) sq[q] = *(const GAS f32x4*)(ssqp + (size_t)row * 16 + 4 * q);
            P6_MMA(bA, 0); P6_MMA(bB, 8); P6_MMA(bC, 16); P6_MMA(bD, 24);
#undef P6_LOADB
#undef P6_MMA
        }
        if (wave >= 4) {
#pragma unroll
            for (int r = 0; r < 16; ++r) xch[((wave & 3) * 20 + r) * 64 + lane] = acc0[r];
#pragma unroll
            for (int r = 0; r < 4; ++r) xch[((wave & 3) * 20 + 16 + r) * 64 + lane] = acc1[r];
        }
        __syncthreads();
        if (wave < 4) {
#pragma unroll
            for (int r = 0; r < 16; ++r) acc0[r] += xch[(wave * 20 + r) * 64 + lane];
#pragma unroll
            for (int r = 0; r < 4; ++r) acc1[r] += xch[(wave * 20 + 16 + r) * 64 + lane];
            float el[32], gl[4];
#pragma unroll
            for (int r = 0; r < 16; ++r) { auto rr = __builtin_amdgcn_permlane32_swap(__float_as_uint(acc0[r]), __float_as_uint(acc0[r]), false, false);
                el[(r & 3) + 8 * (r >> 2)] = __uint_as_float(rr[0]); el[(r & 3) + 8 * (r >> 2) + 4] = __uint_as_float(rr[1]); }
#pragma unroll
            for (int i = 0; i < 4; ++i) { auto rr = __builtin_amdgcn_permlane32_swap(__float_as_uint(acc1[i]), __float_as_uint(acc1[i]), false, false); gl[i] = __uint_as_float(rr[0]); }
            float ss = 0.f;
#pragma unroll
            for (int q = 0; q < 4; ++q) { const f32x4 v = sq[q]; ss += (v.x + v.y) + (v.z + v.w); }
            rs = 1.0f / sqrtf(ss * (1.f / DM) + EPS);
#pragma unroll
            for (int i = 0; i < 4; ++i) gl[i] = gl[i] * rs + bgroup[i];
            int g = 0; float gmx = gl[0];
#pragma unroll
            for (int i = 1; i < 4; ++i) { const bool b = gl[i] > gmx; gmx = b ? gl[i] : gmx; g = b ? i : g; }
            float Z = 0.f;
#pragma unroll
            for (int i = 0; i < 4; ++i) Z += __expf(gl[i] - gmx);
            const float pg = 1.0f / Z;
            float v[8];
#pragma unroll
            for (int j = 0; j < 8; ++j) { const float x = (g == 0) ? el[j] : (g == 1) ? el[8 + j] : (g == 2) ? el[16 + j] : el[24 + j]; v[j] = x * rs + brouter[g * 8 + j]; }
            int i1 = 0; float m1 = v[0];
#pragma unroll
            for (int j = 1; j < 8; ++j) { const bool b = v[j] > m1; m1 = b ? v[j] : m1; i1 = b ? j : i1; }
            int i2 = 0; float m2 = -INFINITY;
#pragma unroll
            for (int j = 0; j < 8; ++j) { const bool b = (j != i1) && (v[j] > m2); m2 = b ? v[j] : m2; i2 = b ? j : i2; }
            const float tt = __expf(m2 - m1); w1 = pg / (1.0f + tt); w2 = pg * tt / (1.0f + tt);
            e1 = g * 8 + i1; e2 = g * 8 + i2;
            if (hi == 0) { p1 = __hip_atomic_fetch_add(lcnt + e1, 1, __ATOMIC_RELAXED, __HIP_MEMORY_SCOPE_WORKGROUP); p2 = __hip_atomic_fetch_add(lcnt + e2, 1, __ATOMIC_RELAXED, __HIP_MEMORY_SCOPE_WORKGROUP); }
        }
        __syncthreads();
        if (tid < 32) lbase[tid] = (int)__hip_atomic_fetch_add(cnt + tid * 16, (unsigned)lcnt[tid], RLX_AGENT);
        __syncthreads();
        if (wave < 4 && hi == 0) {
            ((v4u*)list)[(size_t)e1 * LISTCAP + lbase[e1] + p1] = (v4u){2u * row, __float_as_uint(w1), __float_as_uint(rs), 0u}; ((v4u*)list)[(size_t)e2 * LISTCAP + lbase[e2] + p2] = (v4u){2u * row + 1u, __float_as_uint(w2), __float_as_uint(rs), 0u};
        }
        __syncthreads();
    }
}

__device__ __forceinline__ int moe_prefix(LAS unsigned char* lds, const Args& A, int tid) {
    LAS int* tpre = (LAS int*)(lds + LDSCTL_OFF); LAS int* cnts = (LAS int*)(lds + LDSCTL_OFF + 160);
    unsigned* cnt = (unsigned*)(A.ws + WS_CTL) + CW_CNT;
    __syncthreads();
    if (tid < 32) cnts[tid] = (int)__hip_atomic_load(cnt + tid * 16, RLX_AGENT);
    __syncthreads();
    if (tid == 0) { int s = 0; for (int e = 0; e < NEXP; ++e) { tpre[e] = s; s += (cnts[e] + 255) >> 8; } tpre[NEXP] = s; }
    __syncthreads();
    return tpre[NEXP];
}

__device__ __forceinline__ void p9_final(const Args& A, int vcu, int G, int tid) {
    const int lane = tid & 63, wave = __builtin_amdgcn_readfirstlane(tid >> 6);
    const int gw = vcu * NWAVES + wave, NGW = G * NWAVES;
    f32x4 gv[4];
#pragma unroll
    for (int j = 0; j < 4; ++j) gv[j] = ((const GAS f32x4*)A.in[19])[lane + 64 * j];
    const bf16* x1 = (const bf16*)(A.ws + WS_H); const unsigned char* yc = (const unsigned char*)(A.ws + WS_YC);
    for (int m = gw; m < T; m += NGW) {
        const GAS u32x2* xr = (const GAS u32x2*)(x1 + (size_t)m * DM) + lane;
        const GAS unsigned* y0 = (const GAS unsigned*)(yc + (size_t)(2 * m) * DM) + lane; const GAS unsigned* y1 = (const GAS unsigned*)(yc + (size_t)(2 * m + 1) * DM) + lane;
        f32x4 v[4]; float s = 0.f;
#pragma unroll
        for (int j = 0; j < 4; ++j) { const unsigned a = y0[64 * j], b = y1[64 * j]; const u32x2 c = xr[64 * j];
            const f32x2v a01 = __builtin_amdgcn_cvt_pk_f32_fp8((int)a, false), a23 = __builtin_amdgcn_cvt_pk_f32_fp8((int)a, true), b01 = __builtin_amdgcn_cvt_pk_f32_fp8((int)b, false), b23 = __builtin_amdgcn_cvt_pk_f32_fp8((int)b, true);
            v[j].x = bf2f_lo(c.x) + (a01.x + b01.x) * 0.0625f; v[j].y = bf2f_hi(c.x) + (a01.y + b01.y) * 0.0625f; v[j].z = bf2f_lo(c.y) + (a23.x + b23.x) * 0.0625f; v[j].w = bf2f_hi(c.y) + (a23.y + b23.y) * 0.0625f;
            s += (v[j].x * v[j].x + v[j].y * v[j].y) + (v[j].z * v[j].z + v[j].w * v[j].w); }
        const float rstd = 1.0f / sqrtf(wave_sum(s) * (1.f / DM) + EPS);
        GAS f32x4* o = (GAS f32x4*)(A.out + (size_t)m * DM) + lane;
#pragma unroll
        for (int j = 0; j < 4; ++j) o[64 * j] = v[j] * rstd * gv[j];
    }
}

__global__ void __launch_bounds__(NWAVES * 64, 2) mk_fwd(Args args) {
    extern __shared__ __attribute__((aligned(16))) unsigned char lds[];
    LAS unsigned char* L = (LAS unsigned char*)lds;
    volatile LAS unsigned* MISC = (volatile LAS unsigned*)(L + MISC_OFF);
    const int tid = threadIdx.x;
    const int G = gridDim.x; const int bx = blockIdx.x; const int vcu = (G % 8 == 0) ? (bx % 8) * (G / 8) + bx / 8 : bx;
    unsigned char* ws = args.ws;
    gu32* ctl = (gu32*)(ws + WS_CTL);
    for (int u = tid; u < (LDS_BYTES - LDSCTL_OFF) / 4; u += NWAVES * 64) ((LAS unsigned*)(L + LDSCTL_OFF))[u] = 0u;
    __syncthreads();
    XcdBarrier bar; bar.bar = (unsigned*)(ctl + CW_BAR); bar.x = 0; bar.st = nullptr;
    if (N_LAUNCHES == 1) bar = xcd_barrier_post((unsigned*)(ctl + CW_BAR), MISC + 8);
    const int lo = args.ph_lo, hi = args.ph_hi;
#ifndef PH_MASK
#define PH_MASK 0x3ff
#endif
#define IN(k) (((PH_MASK >> (k)) & 1) && lo <= (k) && (k) < hi)
#define BOTH(k) (IN(k) && IN((k) + 1))
#ifndef DUPBAR
#define DUPBAR 0
#endif
#define GRID_BAR() do { if (N_LAUNCHES == 1) { xcd_barrier(bar); if (DUPBAR) xcd_barrier(bar); } } while (0)
#ifndef DUP_MASK
#define DUP_MASK 0
#endif
#define NREP(k) (1 + ((DUP_MASK >> (k)) & 1))

#define DUP(k) ((DUP_MASK >> (k)) & 1)
#ifndef DUP2_MOBA
#define DUP2_MOBA 0
#endif
#ifndef STAG5
#define STAG5 0
#endif
#ifndef STAG4
#define STAG4 0
#endif
#define STAG_WAIT(ticks) do { if ((ticks) > 0 && (vcu & 1)) { const unsigned long long t0_ = __builtin_amdgcn_s_memrealtime(); while (__builtin_amdgcn_s_memrealtime() - t0_ < (unsigned long long)(ticks)) __builtin_amdgcn_s_sleep(8); } } while (0)
#ifndef SHADOWS
#define SHADOWS 4
#endif
    const int nsh = (N_LAUNCHES == 1 && lo == 0 && hi == N_PHASES && (SHADOWS)) ? 4 : 0;
#define GRID_BAR_SH(s) do { if (N_LAUNCHES == 1) { if ((s) < nsh) xcd_barrier_work(bar, [&](int t, int) { p0_shadow(L, args, vcu, G, (s), t); }); else xcd_barrier(bar); } } while (0)
#define P0_BODY p0_prologue(L, args, vcu, G, tid, nsh)
    if (IN(0)) { P0_BODY; if (DUP(0)) { GRID_BAR(); P0_BODY; } if (BOTH(0)) GRID_BAR_SH(0); }

#define P1_BF16 do { pg8::Gemm g{(const pg8::bf16_t*)(ws + WS_H), (const pg8::bf16_t*)(ws + WS_WIN), T, INC, DM}; pg8::SubOrder<0> S; S.init(T, G, bx);       \
          pg8::gemm_phase<pg8::EpiProj, pg8::SubOrder<0>, true, false>(L + RING_OFF, g, S, E); } while (0)
#define P1_FP8 do { pg8::Gemm g{(const pg8::bf16_t*)(ws + WS_H8), (const pg8::bf16_t*)(ws + WS_WIN8), T, INC, DM / 2, nullptr, nullptr, 0x79797979}; pg8::SubOrder<1> S; S.init(T, G, bx);     \
          pg8::gemm_phase<pg8::EpiProj, pg8::SubOrder<1>, true, false, false, true>(L + RING_OFF, g, S, E); } while (0)
#define P1_BODY do { pg8::EpiProj E{(pg8::bf16_t*)(ws + WS_R6), (pg8::bf16_t*)(ws + WS_GATES), (const float*)(ws + WS_ROPE), (const float*)(ws + WS_ROPE) + SEQ * 32, (float*)(ws + WS_KPART)}; \
        if constexpr (pg8::P1_NB > 0) { P1_BF16; } P1_FP8; } while (0)
#ifndef DUP1_PART
#define DUP1_PART 0
#endif
    if (IN(1)) { P1_BODY; if (DUP(1)) { GRID_BAR(); pg8::EpiProj E{(pg8::bf16_t*)(ws + WS_R6), (pg8::bf16_t*)(ws + WS_GATES), (const float*)(ws + WS_ROPE), (const float*)(ws + WS_ROPE) + SEQ * 32, (float*)(ws + WS_KPART)};
            if (DUP1_PART == 1) { P1_BF16; } else if (DUP1_PART == 2) { P1_FP8; } else { P1_BF16; P1_FP8; } } if (BOTH(1)) GRID_BAR_SH(1); }

    if (IN(2)) { p2_attention<true, true>((char*)lds + RING_OFF, ws, vcu, G, nullptr, (const float*)(ws + WS_ROPE) + 2 * SEQ * 32, args.in[10]);
        if (DUP(2)) { GRID_BAR(); p2_attention<DUP2_MOBA != 0, DUP2_MOBA == 0>((char*)lds + RING_OFF, ws, vcu, G, (void*)args.out, (const float*)(ws + WS_ROPE) + 2 * SEQ * 32, args.in[10]); } if (BOTH(2)) GRID_BAR_SH(2); }

    if (IN(3)) { }

#ifndef P4_TWOPASS
#define P4_TWOPASS 0
#endif
#if P4_TWOPASS
#define P4_BODY do { pg8::StaticOrder S; S.init(T, DM, G, bx); \
        { pg8::Gemm g{(const pg8::bf16_t*)(ws + WS_OA), (const pg8::bf16_t*)(ws + WS_WBM), T, DM, 512}; \
          pg8::EpiMerge<0> E{(pg8::bf16_t*)(ws + WS_MERGED), (const pg8::bf16_t*)(ws + WS_GATES)}; \
          pg8::gemm_phase<pg8::EpiMerge<0>, pg8::StaticOrder, true, false>(L + RING_OFF, g, S, E); } \
        { pg8::Gemm g{(const pg8::bf16_t*)(ws + WS_ODF), (const pg8::bf16_t*)(ws + WS_WBD), T, DM, 512}; \
          pg8::EpiMerge<1> E{(pg8::bf16_t*)(ws + WS_MERGED), (const pg8::bf16_t*)(ws + WS_GATES)}; \
          pg8::gemm_phase<pg8::EpiMerge<1>, pg8::StaticOrder, true, false>(L + RING_OFF, g, S, E); } } while (0)
#else
#define P4_BODY do { STAG_WAIT(STAG4); pg8::StaticOrder S; S.init(T, DM, G, bx); \
        pg8::Gemm g{(const pg8::bf16_t*)(ws + WS_OA), (const pg8::bf16_t*)(ws + WS_WBM), T, DM, 512, (const pg8::bf16_t*)(ws + WS_ODF), (const pg8::bf16_t*)(ws + WS_WBD)}; \
        pg8::EpiMerge2 E{(pg8::bf16_t*)(ws + WS_MERGED), (const pg8::bf16_t*)(ws + WS_GATES)}; \
        pg8::gemm_phase<pg8::EpiMerge2, pg8::StaticOrder, true, false, true>(L + RING_OFF, g, S, E); } while (0)
#endif
    if (IN(4)) { P4_BODY; if (DUP(4)) { GRID_BAR(); P4_BODY; } if (BOTH(4)) GRID_BAR_SH(3); }

#define P5_BODY do { STAG_WAIT(STAG5); pg8::Gemm g{(const pg8::bf16_t*)(ws + WS_MERGED), (const pg8::bf16_t*)(ws + WS_WOUT), T, DM, DM}; pg8::StaticOrder S; S.init(T, DM, G, bx); \
        pg8::EpiRes E{args.in[0], (pg8::bf16_t*)(ws + WS_H), (float*)(ws + WS_SSQP), (unsigned char*)(ws + WS_X1F8)}; \
        pg8::gemm_phase<pg8::EpiRes, pg8::StaticOrder, true, false>(L + RING_OFF, g, S, E); } while (0)
    bool p6_prepped = false;
#ifndef DUP5_NULL
#define DUP5_NULL 0
#endif
#define P5_NULL_BODY do { pg8::Gemm g{(const pg8::bf16_t*)(ws + WS_MERGED), (const pg8::bf16_t*)(ws + WS_WOUT), T, DM, DM}; pg8::StaticOrder S; S.init(T, DM, G, bx); \
        pg8::EpiNull E{(float*)(ws + WS_SSQP)}; \
        pg8::gemm_phase<pg8::EpiNull, pg8::StaticOrder, true, false>(L + RING_OFF, g, S, E); } while (0)
    if (IN(5)) { P5_BODY; if (DUP(5)) { GRID_BAR(); if (DUP5_NULL) { P5_NULL_BODY; } else { P5_BODY; } }
        if (BOTH(5) && N_LAUNCHES == 1) { xcd_barrier_work(bar, [&](int t, int n) { p6_prep(L + RING_OFF, args, t, n); }); p6_prepped = true; } }

    if (IN(6)) { p6_router(L + RING_OFF, args, vcu, G, tid, p6_prepped); if (BOTH(6)) GRID_BAR(); }

#define P7_BODY do { const int ntile = __builtin_amdgcn_readfirstlane(moe_prefix(L, args, tid)); moe_nt = ntile; \
        pg8::Gemm g{(const pg8::bf16_t*)(ws + WS_X1F8), (const pg8::bf16_t*)(ws + WS_W13), T, 1024, DM / 2, nullptr, nullptr, 0x79797979}; \
        pg8::MoeOrder S{(const LAS int*)(L + LDSCTL_OFF), (const LAS int*)(L + LDSCTL_OFF + 160), (const unsigned*)(ws + WS_LIST), G, vcu, 4 * ntile, 1, 1024u}; \
        pg8::EpiAct E{(unsigned char*)(ws + WS_ACT), (const unsigned*)(ws + WS_LIST)}; \
        pg8::gemm_phase<pg8::EpiAct, pg8::MoeOrder, true, true, false, true>(L + RING_OFF, g, S, E); } while (0)
    int moe_nt = 256;
    if (IN(7)) { P7_BODY; if (DUP(7)) { GRID_BAR(); P7_BODY; }
        if (nsh > 0) p0_tail_w2(L, args, vcu, G, 4 * moe_nt, tid);
        if (BOTH(7)) GRID_BAR(); }

#define P8_BODY do { const int ntile = __builtin_amdgcn_readfirstlane(moe_prefix(L, args, tid)); \
        pg8::Gemm g{(const pg8::bf16_t*)(ws + WS_ACT), (const pg8::bf16_t*)(ws + WS_W2), 2 * T, 1024, 256, nullptr, nullptr, 0x7a7a7a7a}; \
        pg8::MoeOrder S{(const LAS int*)(L + LDSCTL_OFF), (const LAS int*)(L + LDSCTL_OFF + 160), (const unsigned*)(ws + WS_LIST), G, vcu, 4 * ntile, 0, 512u}; \
        pg8::EpiDown E{(unsigned char*)(ws + WS_YC), (const unsigned*)(ws + WS_LIST)}; \
        pg8::gemm_phase<pg8::EpiDown, pg8::MoeOrder, true, true, false, true>(L + RING_OFF, g, S, E); } while (0)
    if (IN(8)) { P8_BODY; if (DUP(8)) { GRID_BAR(); P8_BODY; } if (BOTH(8)) GRID_BAR(); }

    if (IN(9)) { p9_final(args, vcu, G, tid); if (DUP(9)) { GRID_BAR(); p9_final(args, vcu, G, tid); } }
#undef IN
#undef BOTH
#undef GRID_BAR
}

extern "C" void kernel_launch(void* const* d_in, const int* in_sizes, int n_in, void* d_out, int out_size, void* d_ws, size_t ws_size, hipStream_t stream) {
    static int grid = 0;
    if (grid == 0) {
        if (n_in != 20 || in_sizes[0] != T * DM || out_size != T * DM || ws_size < WS_END) { fprintf(stderr, "kernel_launch: built for 20 inputs, x/out of %d floats, >= %zu bytes of workspace; got n_in %d, in0 %d, out %d, ws %zu; nothing launched\n", T * DM, (size_t)WS_END, n_in, n_in > 0 ? in_sizes[0] : -1, out_size, ws_size); grid = -1; return; }
        int dev = 0, cus = 0, per_cu = 0;
        if (hipGetDevice(&dev) != hipSuccess || hipDeviceGetAttribute(&cus, hipDeviceAttributeMultiprocessorCount, dev) != hipSuccess) { fprintf(stderr, "kernel_launch: hipGetDevice / hipDeviceGetAttribute failed; nothing launched\n"); grid = -1; return; }
        if (hipFuncSetAttribute((const void*)mk_fwd, hipFuncAttributeMaxDynamicSharedMemorySize, LDS_BYTES) != hipSuccess) { fprintf(stderr, "kernel_launch: hipFuncSetAttribute failed; nothing launched\n"); grid = -1; return; }
        if (hipOccupancyMaxActiveBlocksPerMultiprocessor(&per_cu, (const void*)mk_fwd, NWAVES * 64, LDS_BYTES) != hipSuccess || per_cu < 1)
            fprintf(stderr, "kernel_launch: note: the occupancy query reports %d workgroups per CU\n", per_cu);
        (void)hipGetLastError();
        grid = cus;
    }
    if (grid < 0) return;
    if (hipMemsetAsync((char*)d_ws + WS_CTL, 0, CTL_ZERO_BYTES, stream) != hipSuccess) { fprintf(stderr, "kernel_launch: hipMemsetAsync of the control words failed; nothing launched\n"); return; }
    Args a{};
    for (int i = 0; i < 20; ++i) a.in[i] = (const float*)d_in[i];
    a.out = (float*)d_out; a.ws = (unsigned char*)d_ws;
    for (int li = 0; li < N_LAUNCHES; ++li) {
        a.ph_lo = (N_LAUNCHES == 1) ? 0 : li; a.ph_hi = (N_LAUNCHES == 1) ? N_PHASES : li + 1;
        hipLaunchKernelGGL(mk_fwd, dim3(grid), dim3(NWAVES * 64), LDS_BYTES, stream, a);
        const hipError_t le = hipPeekAtLastError();
        if (le != hipSuccess) { fprintf(stderr, "kernel_launch: launch %d failed: %s\n", li, hipGetErrorName(le)); break; }
    }
}
```
